# Optimizing an MI355X kernel written in HIP

```python
import jax, jax.numpy as jnp
from jax import lax
import numpy as np

D_MODEL = 1024
BATCH = 4
SEQ = 4096
DEPTH = 1

N_META = 16
D_RNN = 1024
N_RNN_HEADS = 4
RNN_HEAD_DIM = D_RNN // N_RNN_HEADS
RNN_CONV_WIDTH = 4
RG_LRU_C = 8.0
D_CONV = 1024
CONV_WIDTH = 31
D_FF = 2816
FFN_RESIDUAL_WEIGHT = 0.5
EPS = 1e-6
IN_SIZES = (D_RNN, D_RNN, D_CONV, D_CONV, D_MODEL, D_MODEL)
IN_TOTAL = sum(IN_SIZES)
IN_SPLITS = tuple(int(v) for v in np.cumsum(IN_SIZES)[:-1])

kernel_name = "hybrid_rglru_conformer_macaron"


def rmsnorm(x, g):
    xf = x.astype(jnp.float32)
    y = xf * lax.rsqrt(jnp.mean(xf * xf, axis=-1, keepdims=True) + EPS)
    return (y * g.astype(jnp.float32)).astype(x.dtype)


def layernorm(x, g, b):
    xf = x.astype(jnp.float32)
    mu = jnp.mean(xf, axis=-1, keepdims=True)
    var = jnp.mean(jnp.square(xf - mu), axis=-1, keepdims=True)
    y = (xf - mu) * lax.rsqrt(var + EPS)
    return (y * g.astype(jnp.float32) + b.astype(jnp.float32)).astype(x.dtype)


def swiglu_ffn(h, w_gu, w_down):
    gate, up = jnp.split(h @ w_gu, 2, axis=-1)
    return (jax.nn.silu(gate) * up) @ w_down


def causal_depthwise_conv(x, w, b):
    k_width, channels = w.shape
    out = lax.conv_general_dilated(
        x, w[:, None, :].astype(x.dtype), window_strides=(1,), padding=((k_width - 1, 0),),
        dimension_numbers=("NWC", "WIO", "NWC"), feature_group_count=channels)
    return out + b


def rg_lru(x, w_a, b_a, w_x, b_x, lam):
    bsz, t_len, _ = x.shape
    xb = x.reshape(bsz, t_len, N_RNN_HEADS, RNN_HEAD_DIM)
    r = jax.nn.sigmoid((jnp.einsum("bthi,hij->bthj", xb, w_a).reshape(bsz, t_len, D_RNN) + b_a).astype(jnp.float32))
    i = jax.nn.sigmoid((jnp.einsum("bthi,hij->bthj", xb, w_x).reshape(bsz, t_len, D_RNN) + b_x).astype(jnp.float32))
    log_a = -RG_LRU_C * r * jax.nn.softplus(-lam.astype(jnp.float32))
    a = jnp.exp(log_a)
    u = jnp.sqrt(-jnp.expm1(2.0 * log_a)) * (i * x.astype(jnp.float32))

    def combine(left, right):
        a_l, h_l = left
        a_r, h_r = right
        return a_l * a_r, a_r * h_l + h_r

    _, h = lax.associative_scan(combine, (a, u), axis=1)
    return h.astype(x.dtype)


def token_mixer(h, w_in, b_in, rnn_conv_w, rnn_conv_b, rg_w_a, rg_b_a, rg_w_x, rg_b_x, rg_lambda,
                rnn_w_proj, conv_dw_w, conv_dw_b, conv_ln_g, conv_ln_b, conv_w_proj, conv_b_proj, w_out):
    proj = h @ w_in + b_in
    x_rnn, y_rnn, glu_v, glu_g, gate_a, gate_b = jnp.split(proj, IN_SPLITS, axis=-1)
    xr = causal_depthwise_conv(x_rnn, rnn_conv_w, rnn_conv_b)
    xr = rg_lru(xr, rg_w_a, rg_b_a, rg_w_x, rg_b_x, rg_lambda)
    y_a = (xr * jax.nn.gelu(y_rnn)) @ rnn_w_proj
    v = glu_v * jax.nn.sigmoid(glu_g)
    v = causal_depthwise_conv(v, conv_dw_w, conv_dw_b)
    v = jax.nn.silu(layernorm(v, conv_ln_g, conv_ln_b))
    y_b = v @ conv_w_proj + conv_b_proj
    merged = jax.nn.sigmoid(gate_a) * y_a + jax.nn.sigmoid(gate_b) * y_b
    return merged @ w_out


def setup_inputs(seed: int = 0) -> dict:
    key = jax.random.key(seed)
    ks = iter(jax.random.split(key, 40))
    L = DEPTH
    f32 = jnp.float32

    def nrm(shape, fan_in):
        return jax.random.normal(next(ks), shape, f32) * (fan_in ** -0.5)

    def gain(shape):
        return 1.0 + 0.02 * jax.random.normal(next(ks), shape, f32)

    def bias(shape):
        return 0.01 * jax.random.normal(next(ks), shape, f32)

    x = jax.random.normal(next(ks), (BATCH, SEQ, D_MODEL), f32)
    meta_tokens = jax.random.normal(next(ks), (N_META, D_MODEL), f32)
    u = jax.random.uniform(next(ks), (L, D_RNN), f32, minval=0.9, maxval=0.999)
    s = u ** (1.0 / RG_LRU_C)
    rg_lambda = jnp.log(s) - jnp.log1p(-s)
    return {
        "x": x,
        "meta_tokens": meta_tokens,
        "ffn1_norm": gain((L, D_MODEL)),
        "ffn1_w_gu": nrm((L, D_MODEL, 2 * D_FF), D_MODEL),
        "ffn1_w_down": nrm((L, D_FF, D_MODEL), D_FF),
        "mix_norm": gain((L, D_MODEL)),
        "w_in": nrm((L, D_MODEL, IN_TOTAL), D_MODEL),
        "b_in": bias((L, IN_TOTAL)),
        "rnn_conv_w": nrm((L, RNN_CONV_WIDTH, D_RNN), RNN_CONV_WIDTH),
        "rnn_conv_b": bias((L, D_RNN)),
        "rg_w_a": nrm((L, N_RNN_HEADS, RNN_HEAD_DIM, RNN_HEAD_DIM), RNN_HEAD_DIM),
        "rg_b_a": bias((L, D_RNN)),
        "rg_w_x": nrm((L, N_RNN_HEADS, RNN_HEAD_DIM, RNN_HEAD_DIM), RNN_HEAD_DIM),
        "rg_b_x": bias((L, D_RNN)),
        "rg_lambda": rg_lambda,
        "rnn_w_proj": nrm((L, D_RNN, D_MODEL), D_RNN),
        "conv_dw_w": nrm((L, CONV_WIDTH, D_CONV), CONV_WIDTH),
        "conv_dw_b": bias((L, D_CONV)),
        "conv_ln_g": gain((L, D_CONV)),
        "conv_ln_b": bias((L, D_CONV)),
        "conv_w_proj": nrm((L, D_CONV, D_MODEL), D_CONV),
        "conv_b_proj": bias((L, D_MODEL)),
        "w_out": nrm((L, D_MODEL, D_MODEL), D_MODEL),
        "ffn2_norm": gain((L, D_MODEL)),
        "ffn2_w_gu": nrm((L, D_MODEL, 2 * D_FF), D_MODEL),
        "ffn2_w_down": nrm((L, D_FF, D_MODEL), D_FF),
        "final_norm": gain((D_MODEL,)),
    }


def reference(x, meta_tokens, ffn1_norm, ffn1_w_gu, ffn1_w_down, mix_norm, w_in, b_in,
              rnn_conv_w, rnn_conv_b, rg_w_a, rg_b_a, rg_w_x, rg_b_x, rg_lambda, rnn_w_proj,
              conv_dw_w, conv_dw_b, conv_ln_g, conv_ln_b, conv_w_proj, conv_b_proj, w_out,
              ffn2_norm, ffn2_w_gu, ffn2_w_down, final_norm):
    bsz = x.shape[0]
    meta = jnp.broadcast_to(meta_tokens.astype(x.dtype)[None], (bsz, N_META, x.shape[-1]))
    h = jnp.concatenate([meta, x], axis=1)
    for l in range(DEPTH):
        h = h + FFN_RESIDUAL_WEIGHT * swiglu_ffn(rmsnorm(h, ffn1_norm[l]), ffn1_w_gu[l], ffn1_w_down[l])
        h = h + token_mixer(rmsnorm(h, mix_norm[l]), w_in[l], b_in[l], rnn_conv_w[l], rnn_conv_b[l],
                            rg_w_a[l], rg_b_a[l], rg_w_x[l], rg_b_x[l], rg_lambda[l], rnn_w_proj[l],
                            conv_dw_w[l], conv_dw_b[l], conv_ln_g[l], conv_ln_b[l], conv_w_proj[l],
                            conv_b_proj[l], w_out[l])
        h = h + FFN_RESIDUAL_WEIGHT * swiglu_ffn(rmsnorm(h, ffn2_norm[l]), ffn2_w_gu[l], ffn2_w_down[l])
    return rmsnorm(h, final_norm)[:, N_META:, :]
```

```cpp
#include <hip/hip_runtime.h>
#include <cstdio>
#include <cstdint>

#ifndef MK_N_LAUNCHES
#define MK_N_LAUNCHES 1
#endif

#define GAS __attribute__((address_space(1)))
#define LAS __attribute__((address_space(3)))
typedef unsigned short bf16;
typedef short bf16x8 __attribute__((ext_vector_type(8)));
typedef float f32x4 __attribute__((ext_vector_type(4)));
typedef float f32x2 __attribute__((ext_vector_type(2)));
typedef unsigned u32x4 __attribute__((ext_vector_type(4)));
typedef unsigned u32x2 __attribute__((ext_vector_type(2)));

constexpr int D = 1024, BATCH = 4, SEQ = 4096, NMETA = 16, DFF = 2816, NIN = 6144;
constexpr int MR = BATCH * SEQ;
constexpr int MROW0 = MR;
constexpr int RB = 16448;
constexpr float EPS = 1e-6f;
constexpr int NPH = 15;
constexpr int NWAVES = 8, NTHREADS = 512;

constexpr size_t MiB = 1u << 20;
constexpr size_t WS_CTL = 0, CTL_ZERO_BYTES = 64 * 1024;
constexpr size_t WS_SS1 = 1 * MiB;
constexpr size_t WS_SS2 = 2 * MiB;
constexpr size_t WS_CS = 3 * MiB;
constexpr size_t WS_CH = 4 * MiB;
constexpr size_t WS_SMALL = 5 * MiB;
constexpr size_t SM_SP8 = 0;
constexpr size_t SM_HM = 4096;
constexpr size_t SM_SSM = SM_HM + 65536;
constexpr size_t SM_MLA = SM_SSM + 4096;
constexpr size_t SM_MUU = SM_MLA + 65536;
constexpr size_t WS_W = 6 * MiB;
constexpr size_t W_GU1 = WS_W, W_D1 = W_GU1 + 11 * MiB, W_IN = W_D1 + 5632 * 1024, W_G = W_IN + 12 * MiB, W_R = W_G + 1 * MiB,
                 W_C = W_R + 2 * MiB, W_O = W_C + 2 * MiB, W_GU2 = W_O + 2 * MiB, W_D2 = W_GU2 + 11 * MiB, W_END = W_D2 + 5632 * 1024;
static_assert(W_END == 58 * MiB, "weights map");
constexpr size_t SLOT = (size_t)RB * D * 2;
constexpr size_t WS_S0 = 58 * MiB;
#define WS_SLOT(i) (WS_S0 + (size_t)(i) * SLOT)
constexpr size_t WS_END = WS_S0 + 6 * SLOT;
static_assert(WS_END <= 256 * MiB, "d_ws map");
static_assert((size_t)RB * DFF * 2 <= 3 * SLOT, "U fits slots 1..3");

constexpr int RING_BYTES = 131072;
constexpr int MISC_OFF = RING_BYTES + 320;
constexpr int LDS_BYTES = 147456;

#define RLX_AGENT __ATOMIC_RELAXED, __HIP_MEMORY_SCOPE_AGENT
__device__ __forceinline__ unsigned cvt_pk_bf16(float lo, float hi) { unsigned r; asm volatile("v_cvt_pk_bf16_f32 %0, %1, %2" : "=v"(r) : "v"(lo), "v"(hi)); return r; }
__device__ __forceinline__ float bf_lo(unsigned w) { return __builtin_bit_cast(float, w << 16); }
__device__ __forceinline__ float bf_hi(unsigned w) { return __builtin_bit_cast(float, w & 0xffff0000u); }
__device__ __forceinline__ float bf2f(bf16 h) { return __builtin_bit_cast(float, (unsigned)h << 16); }
__device__ __forceinline__ float fast_exp(float x) { return __builtin_amdgcn_exp2f(x * 1.44269504089f); }
__device__ __forceinline__ float sigmoidf_(float x) { return __builtin_amdgcn_rcpf(1.0f + fast_exp(-x)); }
__device__ __forceinline__ float gelu_tanh(float x) { const float t = 1.5957691216f * (x + 0.044715f * x * x * x); return x * sigmoidf_(t); }
__device__ __forceinline__ float one_minus_exp(float x) { const float big = 1.0f - fast_exp(x), sm = -x * (1.0f + x * (0.5f + x * (0.16666667f + x * 0.041666668f))); return x > -0.1f ? sm : big; }
__device__ __forceinline__ float siluf_(float x) { return x * sigmoidf_(x); }
__device__ __forceinline__ float wave_sum(float v) {
#pragma unroll
    for (int o = 1; o < 64; o <<= 1) v += __shfl_xor(v, o);
    return v;
}
__device__ __forceinline__ float quad_sum(float v) { v += __shfl_xor(v, 16); v += __shfl_xor(v, 32); return v; }

#define XB_TMO      128
#define XB_XCNT(j)  (256  + 64 * (j))
#define XB_XSUB(j)  (1280 + 64 * (j))
#define XB_XGEN(j)  (2304 + 64 * (j))
#define XB_TOP      3328
#define XB_TOPGEN   3392
#define XCD_BAR_WORDS 3456
#define XB_SPIN_CAP (1u << 18)
__device__ __forceinline__ unsigned xb_ld(unsigned* p)              { return __hip_atomic_load(p, __ATOMIC_RELAXED, __HIP_MEMORY_SCOPE_AGENT); }
__device__ __forceinline__ unsigned xb_add(unsigned* p, unsigned v) { return __hip_atomic_fetch_add(p, v, __ATOMIC_RELAXED, __HIP_MEMORY_SCOPE_AGENT); }
__device__ __forceinline__ unsigned xb_xcc_id() { return (unsigned)__builtin_amdgcn_s_getreg((3 << 11) | 20) & 0xFu; }
#define XB_SPIN(cond, bar) do { unsigned _sp = 0; while (cond) { __builtin_amdgcn_s_sleep(1); \
    if ((++_sp & 255u) == 0u) { if (xb_ld(&(bar)[XB_TMO])) break; if (_sp > XB_SPIN_CAP) { atomicAdd(&(bar)[XB_TMO], 1u); break; } } } } while (0)
struct XcdBarrier { unsigned* bar; unsigned x; volatile LAS unsigned* st; };
__device__ __forceinline__ XcdBarrier xcd_barrier_post(unsigned* bar, volatile LAS unsigned* st) {
    XcdBarrier b; b.bar = bar; b.x = xb_xcc_id(); b.st = st;
    if (threadIdx.x == 0) (void)xb_add(&bar[XB_XCNT(b.x)], 1u);
    return b;
}
__device__ __forceinline__ void xcd_barrier_complete(unsigned* bar, unsigned x, unsigned& nloc, unsigned& nx) {
    const unsigned G = gridDim.x * gridDim.y * gridDim.z;
    unsigned sum, cnt, mine, sp = 0u;
    for (;;) {
        sum = 0u; cnt = 0u; mine = 0u;
#pragma unroll
        for (unsigned j = 0; j < 16; ++j) { const unsigned c = xb_ld(&bar[XB_XCNT(j)]); sum += c; cnt += (c > 0u) ? 1u : 0u; mine = (j == x) ? c : mine; }
        if (sum == G) break;
        __builtin_amdgcn_s_sleep(1);
        if ((++sp & 255u) == 0u) { if (xb_ld(&bar[XB_TMO])) break; if (sp > XB_SPIN_CAP) { atomicAdd(&bar[XB_TMO], 1u); break; } }
    }
    nloc = mine > 0u ? mine : 1u; nx = cnt > 0u ? cnt : 1u;
}
__device__ __forceinline__ void xcd_barrier(const XcdBarrier& b) {
    asm volatile("s_waitcnt vmcnt(0)" ::: "memory");
    __syncthreads();
    if (threadIdx.x == 0) {
        unsigned* bar = b.bar;
        __builtin_amdgcn_s_waitcnt(0);
        unsigned nloc = b.st[0], nx = b.st[1];
        if (nloc == 0u) { xcd_barrier_complete(bar, b.x, nloc, nx); b.st[0] = nloc; b.st[1] = nx; }
        const unsigned old = xb_add(&bar[XB_XSUB(b.x)], 1u);
        const unsigned gen = old / nloc;
        if (old + 1u == (gen + 1u) * nloc) {
            __builtin_amdgcn_fence(__ATOMIC_RELEASE, "agent");
            asm volatile("s_waitcnt vmcnt(0)" ::: "memory");
            const unsigned og = xb_add(&bar[XB_TOP], 1u);
            const unsigned tg = og / nx;
            if (og + 1u == (tg + 1u) * nx) xb_add(&bar[XB_TOPGEN], 1u);
            else XB_SPIN(xb_ld(&bar[XB_TOPGEN]) == tg, bar);
            __builtin_amdgcn_fence(__ATOMIC_ACQUIRE, "agent");
            xb_add(&bar[XB_XGEN(b.x)], 1u);
            asm volatile("s_waitcnt vmcnt(0)" ::: "memory");
        } else {
            XB_SPIN(xb_ld(&bar[XB_XGEN(b.x)]) == gen, bar);
            __builtin_amdgcn_fence(__ATOMIC_ACQUIRE, "agent");
            asm volatile("s_waitcnt vmcnt(0)" ::: "memory");
        }
    }
    __syncthreads();
}

namespace pg8 {
constexpr int BM = 256, HALF = 128, NXCD = 8, WGM = 8;
__host__ __device__ __forceinline__ int perm32(int rho) { const int n = rho >> 4, i = rho & 15; return 8 * (i >> 2) + 4 * n + (i & 3); }
struct Unit { int pm, pn; };
struct Gemm { const bf16* A; const bf16* Bt; int lda, ldb, K, a_tile_cols; };
struct StaticOrder {
    int nM, nN, nwg, G, c;
    __device__ void init(int nM_, int nN_, int G_, int c_) { nM = nM_; nN = nN_; nwg = nM * nN; G = G_; c = c_; }
    __device__ bool next(int i, Unit& u) const {
        const long L = (long)i * G + c; if (L >= nwg) return false;
        int wgid = (int)L; { const int q = nwg / NXCD, r = nwg % NXCD, xcd = wgid % NXCD, off = wgid / NXCD; wgid = (xcd < r ? xcd * (q + 1) : r * (q + 1) + (xcd - r) * q) + off; }
        const int nig = WGM * nN, gid = wgid / nig, fm = gid * WGM, gsz = (nM - fm) < WGM ? (nM - fm) : WGM;
        u.pm = fm + ((wgid % nig) % gsz); u.pn = (wgid % nig) / gsz; return true;
    }
};
typedef f32x4 Acc[2][2][4][2];

__device__ __forceinline__ float rowscale(const float* ss, int row, int fq) {
    const f32x4 p = *(const f32x4*)(ss + (size_t)row * 16 + 4 * fq);
    const float s = quad_sum((p[0] + p[1]) + (p[2] + p[3]));
    return 1.0f / sqrtf(s * (1.0f / D) + EPS);
}
__device__ __forceinline__ u32x4 pack8(const f32x4 a, const f32x4 b) { u32x4 w; w.x = cvt_pk_bf16(a[0], a[1]); w.y = cvt_pk_bf16(a[2], a[3]); w.z = cvt_pk_bf16(b[0], b[1]); w.w = cvt_pk_bf16(b[2], b[3]); return w; }
__device__ __forceinline__ void unpack8(const u32x4 w, f32x4& a, f32x4& b) { a = (f32x4){bf_lo(w.x), bf_hi(w.x), bf_lo(w.y), bf_hi(w.y)}; b = (f32x4){bf_lo(w.z), bf_hi(w.z), bf_lo(w.w), bf_hi(w.w)}; }

struct EpiSwiGLU {
    bf16* U; const float* ss;
    __device__ __forceinline__ void operator()(const Acc& acc, const Unit& u, int wr, int wc, int fr, int fq) const {
        const int row0 = u.pm * BM + wr * 64 + fr, col0 = u.pn * HALF + wc * 32 + 8 * fq;
#pragma unroll
        for (int ai = 0; ai < 2; ++ai)
#pragma unroll
            for (int m = 0; m < 4; ++m) { const int row = row0 + ai * HALF + m * 16; const float rs = ss ? rowscale(ss, row, fq) : 1.0f;
                f32x4 o[2];
#pragma unroll
                for (int n = 0; n < 2; ++n) { const f32x4 g = acc[ai][0][m][n] * rs, v = acc[ai][1][m][n] * rs;
#pragma unroll
                    for (int i = 0; i < 4; ++i) o[n][i] = g[i] * v[i] * sigmoidf_(g[i]); }
                *(u32x4*)(U + (size_t)row * DFF + col0) = pack8(o[0], o[1]); }
    }
};
template <bool HALFSC, bool HAS_A> struct EpiRes {
    const float* base; float* hout; bf16* aout; const float* gvec; float* ssout;
    __device__ __forceinline__ void operator()(const Acc& acc, const Unit& u, int wr, int wc, int fr, int fq) const {
        const int row0 = u.pm * BM + wr * 64 + fr, col0 = u.pn * BM + wc * 32 + 8 * fq;
        const float scale = HALFSC ? 0.5f : 1.0f;
        f32x4 gv[2][2];
#pragma unroll
        for (int bj = 0; bj < 2; ++bj)
#pragma unroll
            for (int n = 0; n < 2; ++n) gv[bj][n] = HAS_A ? *(const f32x4*)(gvec + col0 + bj * HALF + 4 * n) : (f32x4){0.f, 0.f, 0.f, 0.f};
#pragma unroll
        for (int ai = 0; ai < 2; ++ai)
#pragma unroll
            for (int m = 0; m < 4; ++m) { const int row = row0 + ai * HALF + m * 16; const size_t off = (size_t)row * D + col0; float q = 0.f;
#pragma unroll
                for (int bj = 0; bj < 2; ++bj) { f32x4 h[2];
#pragma unroll
                    for (int n = 0; n < 2; ++n) { const f32x4 b = *(const f32x4*)(base + off + bj * HALF + 4 * n); h[n] = b + acc[ai][bj][m][n] * scale;
                        *(f32x4*)(hout + off + bj * HALF + 4 * n) = h[n]; q += (h[n][0] * h[n][0] + h[n][1] * h[n][1]) + (h[n][2] * h[n][2] + h[n][3] * h[n][3]); }
                    if (HAS_A) *(u32x4*)(aout + off + bj * HALF) = pack8(h[0] * gv[bj][0], h[1] * gv[bj][1]); }
                if (HAS_A) { q = quad_sum(q); if (fq == 0) ssout[(size_t)row * 16 + u.pn * 4 + wc] = q; } }
    }
};
struct EpiWin {
    const float* ss; const float* b_in; bf16* s0;
    __device__ __forceinline__ void operator()(const Acc& acc, const Unit& u, int wr, int wc, int fr, int fq) const {
        const int row0 = u.pm * BM + wr * 64 + fr, cc0 = wc * 32 + 8 * fq; const int pn = u.pn;
        if (pn >= 8 && pn < 16) {
            const int q = pn - 8, col = q * HALF + cc0;
            f32x4 bv[2][2];
#pragma unroll
            for (int bj = 0; bj < 2; ++bj)
#pragma unroll
                for (int n = 0; n < 2; ++n) bv[bj][n] = *(const f32x4*)(b_in + 2048 + bj * 1024 + col + 4 * n);
#pragma unroll
            for (int ai = 0; ai < 2; ++ai)
#pragma unroll
                for (int m = 0; m < 4; ++m) { const int row = row0 + ai * HALF + m * 16; const float rs = rowscale(ss, row, fq); f32x4 o[2];
#pragma unroll
                    for (int n = 0; n < 2; ++n) { const f32x4 a = acc[ai][0][m][n] * rs + bv[0][n], g = acc[ai][1][m][n] * rs + bv[1][n];
#pragma unroll
                        for (int i = 0; i < 4; ++i) o[n][i] = a[i] * sigmoidf_(g[i]); }
                    *(u32x4*)(s0 + 3 * (SLOT / 2) + (size_t)row * D + col) = pack8(o[0], o[1]); }
        } else {
            const int act = pn < 4 ? 0 : (pn < 8 ? 1 : 2);
            const int si = pn < 4 ? 1 : (pn < 8 ? 2 : (pn < 20 ? 4 : 5)); bf16* O = s0 + (size_t)si * (SLOT / 2);
            const int scol = pn * BM + cc0, ocol = (pn & 3) * BM + cc0;
            f32x4 bv[2][2];
#pragma unroll
            for (int bj = 0; bj < 2; ++bj)
#pragma unroll
                for (int n = 0; n < 2; ++n) bv[bj][n] = *(const f32x4*)(b_in + scol + bj * HALF + 4 * n);
#pragma unroll
            for (int ai = 0; ai < 2; ++ai)
#pragma unroll
                for (int m = 0; m < 4; ++m) { const int row = row0 + ai * HALF + m * 16; const float rs = rowscale(ss, row, fq);
#pragma unroll
                    for (int bj = 0; bj < 2; ++bj) { f32x4 o[2];
#pragma unroll
                        for (int n = 0; n < 2; ++n) { o[n] = acc[ai][bj][m][n] * rs + bv[bj][n];
                            if (act == 1) {
#pragma unroll
                                for (int i = 0; i < 4; ++i) o[n][i] = gelu_tanh(o[n][i]); }
                            else if (act == 2) {
#pragma unroll
                                for (int i = 0; i < 4; ++i) o[n][i] = sigmoidf_(o[n][i]); } }
                        *(u32x4*)(O + (size_t)row * D + ocol + bj * HALF) = pack8(o[0], o[1]); } }
        }
    }
};
struct EpiYb {
    bf16* sb; const float* bias;
    __device__ __forceinline__ void operator()(const Acc& acc, const Unit& u, int wr, int wc, int fr, int fq) const {
        const int row0 = u.pm * BM + wr * 64 + fr, col0 = u.pn * BM + wc * 32 + 8 * fq;
        f32x4 bv[2][2];
#pragma unroll
        for (int bj = 0; bj < 2; ++bj)
#pragma unroll
            for (int n = 0; n < 2; ++n) bv[bj][n] = *(const f32x4*)(bias + col0 + bj * HALF + 4 * n);
#pragma unroll
        for (int ai = 0; ai < 2; ++ai)
#pragma unroll
            for (int m = 0; m < 4; ++m) { const size_t off = (size_t)(row0 + ai * HALF + m * 16) * D + col0;
#pragma unroll
                for (int bj = 0; bj < 2; ++bj) { f32x4 s0, s1; unpack8(*(const u32x4*)(sb + off + bj * HALF), s0, s1);
                    *(u32x4*)(sb + off + bj * HALF) = pack8(s0 * (acc[ai][bj][m][0] + bv[bj][0]), s1 * (acc[ai][bj][m][1] + bv[bj][1])); } }
    }
};
struct EpiYa {
    const bf16* sa; bf16* mb;
    __device__ __forceinline__ void operator()(const Acc& acc, const Unit& u, int wr, int wc, int fr, int fq) const {
        const int row0 = u.pm * BM + wr * 64 + fr, col0 = u.pn * BM + wc * 32 + 8 * fq;
#pragma unroll
        for (int ai = 0; ai < 2; ++ai)
#pragma unroll
            for (int m = 0; m < 4; ++m) { const size_t off = (size_t)(row0 + ai * HALF + m * 16) * D + col0;
#pragma unroll
                for (int bj = 0; bj < 2; ++bj) { f32x4 s0, s1, b0, b1; unpack8(*(const u32x4*)(sa + off + bj * HALF), s0, s1); unpack8(*(const u32x4*)(mb + off + bj * HALF), b0, b1);
                    *(u32x4*)(mb + off + bj * HALF) = pack8(s0 * acc[ai][bj][m][0] + b0, s1 * acc[ai][bj][m][1] + b1); } }
    }
};
struct EpiGates {
    const bf16* xr; bf16 *la, *uu; const float *b_a, *b_x, *sp8;
    __device__ __forceinline__ void operator()(const Acc& acc, const Unit& u, int wr, int wc, int fr, int fq) const {
        const int row0 = u.pm * BM + wr * 64 + fr, col0 = u.pn * HALF + wc * 32 + 8 * fq;
#pragma unroll
        for (int ai = 0; ai < 2; ++ai)
#pragma unroll
            for (int m = 0; m < 4; ++m) { const size_t off = (size_t)(row0 + ai * HALF + m * 16) * D + col0;
                f32x4 x[2]; unpack8(*(const u32x4*)(xr + off), x[0], x[1]); f32x4 ol[2], ou[2];
#pragma unroll
                for (int n = 0; n < 2; ++n) { const f32x4 ba = *(const f32x4*)(b_a + col0 + 4 * n), bx = *(const f32x4*)(b_x + col0 + 4 * n), sp = *(const f32x4*)(sp8 + col0 + 4 * n);
#pragma unroll
                    for (int i = 0; i < 4; ++i) { const float r = sigmoidf_(acc[ai][0][m][n][i] + ba[i]), ig = sigmoidf_(acc[ai][1][m][n][i] + bx[i]);
                        const float l = -r * sp[i]; ol[n][i] = l; ou[n][i] = __builtin_amdgcn_sqrtf(one_minus_exp(2.0f * l)) * ig * x[n][i]; } }
                *(u32x4*)(la + off) = pack8(ol[0], ol[1]); *(u32x4*)(uu + off) = pack8(ou[0], ou[1]); }
    }
};

template <class Epi>
__device__ __forceinline__ void gemm_phase(LAS unsigned char*, const Gemm g, const StaticOrder& S, const Epi& E) {
    const int tid = threadIdx.x, wid = __builtin_amdgcn_readfirstlane(tid >> 6), lane = tid & 63, wr = wid >> 2, wc = wid & 3, fr = lane & 15, fq = lane >> 4;
    Unit u;
    const int brow0 = perm32(fr), brow1 = perm32(16 + fr);
    for (int ui = 0; S.next(ui, u); ++ui) {
        Acc acc;
#pragma unroll
        for (int a = 0; a < 2; ++a)
#pragma unroll
            for (int b = 0; b < 2; ++b)
#pragma unroll
                for (int m = 0; m < 4; ++m)
#pragma unroll
                    for (int n = 0; n < 2; ++n) acc[a][b][m][n] = (f32x4){0.f, 0.f, 0.f, 0.f};
        const bf16* Ab = g.A + (size_t)(u.pm * BM + wr * 64 + fr) * g.lda + (u.pn >> 1) * g.a_tile_cols + fq * 8;
        const bf16* Bb = g.Bt + (size_t)(u.pn * BM + wc * 32) * g.ldb + fq * 8;
#pragma unroll 1
        for (int k0 = 0; k0 < g.K; k0 += 32) {
            bf16x8 Af[2][4], Bf[2][2];
#pragma unroll
            for (int ai = 0; ai < 2; ++ai)
#pragma unroll
                for (int m = 0; m < 4; ++m) Af[ai][m] = *(const bf16x8*)(Ab + (size_t)(ai * HALF + m * 16) * g.lda + k0);
#pragma unroll
            for (int bj = 0; bj < 2; ++bj) { Bf[bj][0] = *(const bf16x8*)(Bb + (size_t)(bj * HALF + brow0) * g.ldb + k0); Bf[bj][1] = *(const bf16x8*)(Bb + (size_t)(bj * HALF + brow1) * g.ldb + k0); }
#pragma unroll
            for (int ai = 0; ai < 2; ++ai)
#pragma unroll
                for (int bj = 0; bj < 2; ++bj)
#pragma unroll
                    for (int m = 0; m < 4; ++m)
#pragma unroll
                        for (int n = 0; n < 2; ++n) acc[ai][bj][m][n] = __builtin_amdgcn_mfma_f32_16x16x32_bf16(Bf[bj][n], Af[ai][m], acc[ai][bj][m][n], 0, 0, 0);
        }
        E(acc, u, wr, wc, fr, fq);
    }
}
}

struct Frame {
    LAS unsigned char* lds;
    int tid, lane, wave, vcu, G;
    unsigned char* ws;
};
struct Args { const float* in[27]; float* out; unsigned char* ws; int ph_lo, ph_hi; };
enum { I_X = 0, I_META, I_N1, I_GU1, I_D1, I_NMIX, I_WIN, I_BIN, I_CW4, I_CB4, I_WA, I_BA, I_WX, I_BX, I_LAM, I_WR, I_CW31, I_CB31, I_LNG, I_LNB, I_WC, I_BC, I_WO, I_N2, I_GU2, I_D2, I_NF };

__device__ __forceinline__ int row_of(int b, int q) { return q >= NMETA ? b * SEQ + (q - NMETA) : MROW0 + q; }

__device__ __forceinline__ void transpose_item(const float* src, int ld, int scol, int k0, bf16* dst, int drow, int K, LAS float* scr, int lane) {
#pragma unroll 8
    for (int i = 0; i < 32; ++i) { const int kk = 2 * i + (lane >> 5); scr[kk * 33 + (lane & 31)] = src[(size_t)(k0 + kk) * ld + scol + (lane & 31)]; }
    asm volatile("s_waitcnt lgkmcnt(0)" ::: "memory");
    const int c = lane & 7;
#pragma unroll
    for (int j = 0; j < 4; ++j) { const int n = (lane >> 3) + 8 * j; const LAS float* s = scr + (8 * c) * 33 + n;
        u32x4 o; o.x = cvt_pk_bf16(s[0 * 33], s[1 * 33]); o.y = cvt_pk_bf16(s[2 * 33], s[3 * 33]); o.z = cvt_pk_bf16(s[4 * 33], s[5 * 33]); o.w = cvt_pk_bf16(s[6 * 33], s[7 * 33]);
        *(u32x4*)(dst + (size_t)(drow + n) * K + k0 + 8 * c) = o; }
    asm volatile("s_waitcnt lgkmcnt(0)" ::: "memory");
}
__device__ __forceinline__ void wsrc(const Args& a, int kind, int d, const float*& src, int& ld, int& col) {
    switch (kind) {
        case 0: case 7: { src = a.in[kind == 0 ? I_GU1 : I_GU2]; ld = 2 * DFF; col = (d & 1) * DFF + 128 * (d >> 1); break; }
        case 1: case 8: { src = a.in[kind == 1 ? I_D1 : I_D2]; ld = D; col = 128 * d; break; }
        case 2: { src = a.in[I_WIN]; ld = NIN; if (d >= 16 && d < 32) { const int e = d - 16; col = 2048 + (e & 1) * 1024 + 128 * (e >> 1); } else col = 128 * d; break; }
        case 3: { const int h = d >> 2, q = (d >> 1) & 1; src = a.in[(d & 1) ? I_WX : I_WA] + (size_t)h * 256 * 256; ld = 256; col = 128 * q; break; }
        case 4: { src = a.in[I_WR]; ld = D; col = 128 * d; break; }
        case 5: { src = a.in[I_WC]; ld = D; col = 128 * d; break; }
        default: { src = a.in[I_WO]; ld = D; col = 128 * d; break; }
    }
}
__device__ __forceinline__ void rms_row_to_bf16(const float* xrow, const float* g, bf16* orow, int lane) {
    const f32x4* xr = (const f32x4*)xrow + lane; f32x4 v[4]; float s = 0.f;
#pragma unroll
    for (int j = 0; j < 4; ++j) { v[j] = xr[64 * j]; s += (v[j][0] * v[j][0] + v[j][1] * v[j][1]) + (v[j][2] * v[j][2] + v[j][3] * v[j][3]); }
    const float rs = 1.0f / sqrtf(wave_sum(s) * (1.0f / D) + EPS);
#pragma unroll
    for (int j = 0; j < 4; ++j) { const f32x4 gg = ((const f32x4*)g)[lane + 64 * j]; const f32x4 o = v[j] * rs * gg;
        u32x2 w; w.x = cvt_pk_bf16(o[0], o[1]); w.y = cvt_pk_bf16(o[2], o[3]); ((u32x2*)orow)[lane + 64 * j] = w; }
}
__device__ __forceinline__ void p0_prologue(const Args& a, Frame& F) {
    LAS float* scr = (LAS float*)(F.lds + F.wave * 16384);
    const int gw = F.vcu * NWAVES + F.wave, NGW = F.G * NWAVES;
    const int   mK[9]  = {D, DFF, D, 256, D, D, D, D, DFF};
    const int   mNB[9] = {44, 8, 48, 16, 8, 8, 8, 44, 8};
    const size_t mDst[9] = {W_GU1, W_D1, W_IN, W_G, W_R, W_C, W_O, W_GU2, W_D2};
    int base = 0;
#pragma unroll
    for (int kind = 0; kind < 9; ++kind) {
        const int K = mK[kind], nkb = K / 64, nitems = mNB[kind] * 4 * nkb;
        bf16* dst = (bf16*)(a.ws + mDst[kind]);
        int first = (gw - base % NGW + NGW) % NGW;
        for (int it = first; it < nitems; it += NGW) {
            const int kb = it % nkb, ns = it / nkb, d = ns >> 2, s = ns & 3;
            const float* src; int ld, col; wsrc(a, kind, d, src, ld, col);
            transpose_item(src, ld, col + 32 * s, 64 * kb, dst, 128 * d + 32 * s, K, scr, F.lane);
        }
        base += nitems;
    }
    { float* sp8 = (float*)(a.ws + WS_SMALL + SM_SP8); const int gt = F.vcu * NTHREADS + F.tid; if (gt < D) sp8[gt] = 8.0f * log1pf(expf(-a.in[I_LAM][gt])); }
    bf16* A1 = (bf16*)(a.ws + WS_SLOT(0));
    for (int r = gw; r < MR + NMETA; r += NGW) { const float* xrow = r < MR ? a.in[I_X] + (size_t)r * D : a.in[I_META] + (size_t)(r - MR) * D; rms_row_to_bf16(xrow, a.in[I_N1], A1 + (size_t)r * D, F.lane); }
}

__device__ __forceinline__ f32x4 meta_dot(const bf16* arow  , const bf16* brow  , int K) {
    f32x4 acc = {0.f, 0.f, 0.f, 0.f};
#pragma unroll 4
    for (int k0 = 0; k0 < K; k0 += 32) { const bf16x8 af = *(const bf16x8*)(arow + k0), bfr = *(const bf16x8*)(brow + k0); acc = __builtin_amdgcn_mfma_f32_16x16x32_bf16(bfr, af, acc, 0, 0, 0); }
    return acc;
}
__device__ __forceinline__ void meta_m1(const Args& a, int t, int lane) {
    const int fr = lane & 15, fq = lane >> 4; const bf16* A1 = (const bf16*)(a.ws + WS_SLOT(0)); const bf16* W = (const bf16*)(a.ws + W_GU1); bf16* U = (bf16*)(a.ws + WS_SLOT(1));
    const int c0 = 16 * t, pn = c0 >> 7, cc = c0 & 127; const bf16* ar = A1 + (size_t)(MROW0 + fr) * D + 8 * fq;
    const f32x4 g = meta_dot(ar, W + (size_t)(256 * pn + cc + fr) * D + 8 * fq, D), v = meta_dot(ar, W + (size_t)(256 * pn + 128 + cc + fr) * D + 8 * fq, D);
    u32x2 w; w.x = cvt_pk_bf16(g[0] * v[0] * sigmoidf_(g[0]), g[1] * v[1] * sigmoidf_(g[1])); w.y = cvt_pk_bf16(g[2] * v[2] * sigmoidf_(g[2]), g[3] * v[3] * sigmoidf_(g[3]));
    *(u32x2*)(U + (size_t)(MROW0 + fr) * DFF + c0 + 4 * fq) = w;
}
__device__ __forceinline__ void meta_m2(const Args& a, int t, int lane) {
    const int fr = lane & 15, fq = lane >> 4; const bf16* U = (const bf16*)(a.ws + WS_SLOT(1)); const bf16* W = (const bf16*)(a.ws + W_D1);
    const int c0 = 16 * t + 4 * fq;
    const f32x4 acc = meta_dot(U + (size_t)(MROW0 + fr) * DFF + 8 * fq, W + (size_t)(16 * t + fr) * DFF + 8 * fq, DFF);
    const f32x4 h = *(const f32x4*)(a.in[I_META] + (size_t)fr * D + c0) + acc * 0.5f;
    *(f32x4*)((float*)(a.ws + WS_SMALL + SM_HM) + (size_t)fr * D + c0) = h;
    const f32x4 o = h * *(const f32x4*)(a.in[I_NMIX] + c0); u32x2 w; w.x = cvt_pk_bf16(o[0], o[1]); w.y = cvt_pk_bf16(o[2], o[3]);
    *(u32x2*)((bf16*)(a.ws + WS_SLOT(0)) + (size_t)(MROW0 + fr) * D + c0) = w;
    const float q = quad_sum((h[0] * h[0] + h[1] * h[1]) + (h[2] * h[2] + h[3] * h[3]));
    if (fq == 0) ((float*)(a.ws + WS_SMALL + SM_SSM))[fr * 64 + t] = q;
}
__device__ __forceinline__ void meta_m3(const Args& a, int t, int lane) {
    const int fr = lane & 15, fq = lane >> 4; const bf16* A2 = (const bf16*)(a.ws + WS_SLOT(0)); const bf16* W = (const bf16*)(a.ws + W_IN);
    const float* ssm = (const float*)(a.ws + WS_SMALL + SM_SSM) + fr * 64 + 16 * fq; float s = 0.f;
#pragma unroll
    for (int j = 0; j < 4; ++j) { const f32x4 p = *(const f32x4*)(ssm + 4 * j); s += (p[0] + p[1]) + (p[2] + p[3]); }
    const float rs = 1.0f / sqrtf(quad_sum(s) * (1.0f / D) + EPS);
    const bf16* ar = A2 + (size_t)(MROW0 + fr) * D + 8 * fq;
    if (t < 64) { const int c0 = 16 * t;
        const f32x4 acc = meta_dot(ar, W + (size_t)(c0 + fr) * D + 8 * fq, D);
        const f32x4 o = acc * rs + *(const f32x4*)(a.in[I_BIN] + c0 + 4 * fq); u32x2 w; w.x = cvt_pk_bf16(o[0], o[1]); w.y = cvt_pk_bf16(o[2], o[3]);
        *(u32x2*)((bf16*)(a.ws + WS_SLOT(1)) + (size_t)(MROW0 + fr) * D + c0 + 4 * fq) = w;
    } else { const int c0 = 16 * (t - 64), q = c0 >> 7, cc = c0 & 127;
        const f32x4 av = meta_dot(ar, W + (size_t)(2048 + 256 * q + cc + fr) * D + 8 * fq, D), ag = meta_dot(ar, W + (size_t)(2048 + 256 * q + 128 + cc + fr) * D + 8 * fq, D);
        const f32x4 vv = av * rs + *(const f32x4*)(a.in[I_BIN] + 2048 + c0 + 4 * fq), gg = ag * rs + *(const f32x4*)(a.in[I_BIN] + 3072 + c0 + 4 * fq);
        u32x2 w; w.x = cvt_pk_bf16(vv[0] * sigmoidf_(gg[0]), vv[1] * sigmoidf_(gg[1])); w.y = cvt_pk_bf16(vv[2] * sigmoidf_(gg[2]), vv[3] * sigmoidf_(gg[3]));
        *(u32x2*)((bf16*)(a.ws + WS_SLOT(3)) + (size_t)(MROW0 + fr) * D + c0 + 4 * fq) = w;
    }
}
__device__ __forceinline__ float meta_conv4(const Args& a, const bf16* X, int m, int c) {
    float s = a.in[I_CB4][c];
#pragma unroll
    for (int k = 0; k < 4; ++k) { const int mm = m - 3 + k; if (mm >= 0) s += a.in[I_CW4][k * D + c] * bf2f(X[(size_t)(MROW0 + mm) * D + c]); }
    return s;
}
__device__ __forceinline__ void meta_m4(const Args& a, int t, int lane) {
    const int fr = lane & 15, fq = lane >> 4; const bf16* X = (const bf16*)(a.ws + WS_SLOT(1)); const bf16* W = (const bf16*)(a.ws + W_G);
    const int c0 = 16 * t, h = c0 >> 8, q = (c0 >> 7) & 1, cc = c0 & 127;
    const bf16* br = W + (size_t)((2 * h + q) * 256 + cc + fr) * 256 + 8 * fq; const bf16* bi = br + (size_t)128 * 256;
    f32x4 ar = {0.f, 0.f, 0.f, 0.f}, ai = {0.f, 0.f, 0.f, 0.f};
    for (int k0 = 0; k0 < 256; k0 += 32) { bf16x8 af;
#pragma unroll
        for (int j = 0; j < 8; j += 2) { const unsigned w = cvt_pk_bf16(meta_conv4(a, X, fr, 256 * h + k0 + 8 * fq + j), meta_conv4(a, X, fr, 256 * h + k0 + 8 * fq + j + 1)); af[j] = (short)(w & 0xffffu); af[j + 1] = (short)(w >> 16); }
        ar = __builtin_amdgcn_mfma_f32_16x16x32_bf16(*(const bf16x8*)(br + k0), af, ar, 0, 0, 0); ai = __builtin_amdgcn_mfma_f32_16x16x32_bf16(*(const bf16x8*)(bi + k0), af, ai, 0, 0, 0); }
    const float* sp8 = (const float*)(a.ws + WS_SMALL + SM_SP8); f32x4 ol, ou;
#pragma unroll
    for (int i = 0; i < 4; ++i) { const int c = c0 + 4 * fq + i; const float r = sigmoidf_(ar[i] + a.in[I_BA][c]), ig = sigmoidf_(ai[i] + a.in[I_BX][c]);
        const float l = -r * sp8[c]; ol[i] = l; ou[i] = __builtin_amdgcn_sqrtf(one_minus_exp(2.0f * l)) * ig * meta_conv4(a, X, fr, c); }
    *(f32x4*)((float*)(a.ws + WS_SMALL + SM_MLA) + (size_t)fr * D + c0 + 4 * fq) = ol; *(f32x4*)((float*)(a.ws + WS_SMALL + SM_MUU) + (size_t)fr * D + c0 + 4 * fq) = ou;
}
template <int WHICH> __device__ __forceinline__ void meta_tasks(const Args& a, Frame& F, int ntasks) {
    for (int t = F.wave * F.G + (int)blockIdx.x; t < ntasks; t += NWAVES * F.G) {
        if (WHICH == 1) meta_m1(a, t, F.lane); else if (WHICH == 2) meta_m2(a, t, F.lane); else if (WHICH == 3) meta_m3(a, t, F.lane); else meta_m4(a, t, F.lane);
    }
}

__device__ __forceinline__ f32x2 ld_bf2(const bf16* p) { const unsigned w = *(const unsigned*)p; return (f32x2){bf_lo(w), bf_hi(w)}; }
__device__ __forceinline__ void phase_conv31(const Args& a, Frame& F) {
    const bf16* V = (const bf16*)(a.ws + WS_SLOT(3)); bf16* O = (bf16*)(a.ws + WS_SLOT(0));
    LAS float* cv = (LAS float*)F.lds;
    const int c0 = 2 * F.tid;
    f32x2 wk[31];
#pragma unroll
    for (int k = 0; k < 31; ++k) wk[k] = *(const f32x2*)(a.in[I_CW31] + k * D + c0);
    const f32x2 bias = *(const f32x2*)(a.in[I_CB31] + c0);
    for (int u = F.vcu; u < 256; u += F.G) {
        const int b = u >> 6, t0 = (u & 63) * 64;
        f32x2 win[38];
#pragma unroll
        for (int i = 0; i < 30; ++i) { const int q = NMETA + t0 - 30 + i; win[i] = q >= 0 ? ld_bf2(V + (size_t)row_of(b, q) * D + c0) : (f32x2){0.f, 0.f}; }
        for (int grp = 0; grp < 4; ++grp) {
#pragma unroll
            for (int sub = 0; sub < 2; ++sub) {
                const int tb = t0 + grp * 16 + sub * 8;
#pragma unroll
                for (int j = 0; j < 8; ++j) win[30 + j] = ld_bf2(V + (size_t)(b * SEQ + tb + j) * D + c0);
#pragma unroll
                for (int j = 0; j < 8; ++j) { f32x2 o = bias;
#pragma unroll
                    for (int k = 0; k < 31; ++k) o += wk[k] * win[j + k];
                    *(LAS f32x2*)(cv + (sub * 8 + j) * D + c0) = o; }
#pragma unroll
                for (int i = 0; i < 30; ++i) win[i] = win[i + 8];
            }
            __syncthreads();
#pragma unroll
            for (int tt = 0; tt < 2; ++tt) { const int tok = 2 * F.wave + tt; const LAS f32x4* rowp = (const LAS f32x4*)(cv + tok * D) + F.lane;
                f32x4 x[4]; float s = 0.f;
#pragma unroll
                for (int j = 0; j < 4; ++j) { x[j] = rowp[64 * j]; s += (x[j][0] + x[j][1]) + (x[j][2] + x[j][3]); }
                const float mean = wave_sum(s) * (1.0f / D); float s2 = 0.f;
#pragma unroll
                for (int j = 0; j < 4; ++j) { x[j] = x[j] - mean; s2 += (x[j][0] * x[j][0] + x[j][1] * x[j][1]) + (x[j][2] * x[j][2] + x[j][3] * x[j][3]); }
                const float rstd = 1.0f / sqrtf(wave_sum(s2) * (1.0f / D) + EPS);
                bf16* orow = O + (size_t)(b * SEQ + t0 + grp * 16 + tok) * D;
#pragma unroll
                for (int j = 0; j < 4; ++j) { const f32x4 g = ((const f32x4*)a.in[I_LNG])[F.lane + 64 * j], bb = ((const f32x4*)a.in[I_LNB])[F.lane + 64 * j]; const f32x4 y = x[j] * rstd * g + bb;
                    u32x2 w; w.x = cvt_pk_bf16(siluf_(y[0]), siluf_(y[1])); w.y = cvt_pk_bf16(siluf_(y[2]), siluf_(y[3])); ((u32x2*)orow)[F.lane + 64 * j] = w; } }
            __syncthreads();
        }
    }
}
__device__ __forceinline__ void phase_conv4(const Args& a, Frame& F) {
    const bf16* X = (const bf16*)(a.ws + WS_SLOT(1)); bf16* O = (bf16*)(a.ws + WS_SLOT(3));
    const int gt = F.vcu * NTHREADS + F.tid, NT = F.G * NTHREADS;
    for (int it = gt; it < MR * 128; it += NT) {
        const int r = it >> 7, c = (it & 127) * 8, b = r >> 12, p = NMETA + (r & 4095);
        f32x4 o0 = *(const f32x4*)(a.in[I_CB4] + c), o1 = *(const f32x4*)(a.in[I_CB4] + c + 4);
#pragma unroll
        for (int k = 0; k < 4; ++k) { f32x4 x0, x1; pg8::unpack8(*(const u32x4*)(X + (size_t)row_of(b, p - 3 + k) * D + c), x0, x1);
            o0 += *(const f32x4*)(a.in[I_CW4] + k * D + c) * x0; o1 += *(const f32x4*)(a.in[I_CW4] + k * D + c + 4) * x1; }
        *(u32x4*)(O + (size_t)r * D + c) = pg8::pack8(o0, o1);
    }
}
__device__ __forceinline__ void phase_scan1(const Args& a, Frame& F) {
    const bf16* LA = (const bf16*)(a.ws + WS_SLOT(0)); const bf16* UU = (const bf16*)(a.ws + WS_SLOT(1));
    float* CS = (float*)(a.ws + WS_CS); float* CH = (float*)(a.ws + WS_CH);
    const int c0 = 2 * F.tid;
    for (int u = F.vcu; u < 256; u += F.G) {
        const size_t r0 = (size_t)u * 64; f32x2 S = {0.f, 0.f}, H = {0.f, 0.f};
#pragma unroll 16
        for (int t = 0; t < 64; ++t) { const f32x2 l = ld_bf2(LA + (r0 + t) * D + c0), x = ld_bf2(UU + (r0 + t) * D + c0);
            H.x = fast_exp(l.x) * H.x + x.x; H.y = fast_exp(l.y) * H.y + x.y; S += l; }
        *(f32x2*)(CS + (size_t)u * D + c0) = S; *(f32x2*)(CH + (size_t)u * D + c0) = H;
    }
}
__device__ __forceinline__ void phase_scan2(const Args& a, Frame& F) {
    const bf16* LA = (const bf16*)(a.ws + WS_SLOT(0)); bf16* UU = (bf16*)(a.ws + WS_SLOT(1)); const bf16* GY = (const bf16*)(a.ws + WS_SLOT(2));
    const float* CS = (const float*)(a.ws + WS_CS); const float* CH = (const float*)(a.ws + WS_CH);
    const float* MLA = (const float*)(a.ws + WS_SMALL + SM_MLA); const float* MUU = (const float*)(a.ws + WS_SMALL + SM_MUU);
    const int c0 = 2 * F.tid;
    for (int u = F.vcu; u < 256; u += F.G) {
        const int b = u >> 6, j = u & 63; const size_t r0 = (size_t)u * 64; f32x2 h = {0.f, 0.f};
#pragma unroll
        for (int s = 0; s < NMETA; ++s) { const f32x2 l = *(const f32x2*)(MLA + s * D + c0), x = *(const f32x2*)(MUU + s * D + c0); h.x = fast_exp(l.x) * h.x + x.x; h.y = fast_exp(l.y) * h.y + x.y; }
        for (int jj = 0; jj < j; ++jj) { const f32x2 l = *(const f32x2*)(CS + (size_t)(b * 64 + jj) * D + c0), x = *(const f32x2*)(CH + (size_t)(b * 64 + jj) * D + c0); h.x = fast_exp(l.x) * h.x + x.x; h.y = fast_exp(l.y) * h.y + x.y; }
#pragma unroll 16
        for (int t = 0; t < 64; ++t) { const f32x2 l = ld_bf2(LA + (r0 + t) * D + c0), x = ld_bf2(UU + (r0 + t) * D + c0), g = ld_bf2(GY + (r0 + t) * D + c0);
            h.x = fast_exp(l.x) * h.x + x.x; h.y = fast_exp(l.y) * h.y + x.y;
            *(unsigned*)(UU + (r0 + t) * D + c0) = cvt_pk_bf16(h.x * g.x, h.y * g.y); }
    }
}
__device__ __forceinline__ void phase_final(const Args& a, Frame& F) {
    const int gw = F.vcu * NWAVES + F.wave, NGW = F.G * NWAVES;
    for (int r = gw; r < MR; r += NGW) { f32x4* xr = (f32x4*)(a.out + (size_t)r * D) + F.lane; f32x4 v[4]; float s = 0.f;
#pragma unroll
        for (int j = 0; j < 4; ++j) { v[j] = xr[64 * j]; s += (v[j][0] * v[j][0] + v[j][1] * v[j][1]) + (v[j][2] * v[j][2] + v[j][3] * v[j][3]); }
        const float rs = 1.0f / sqrtf(wave_sum(s) * (1.0f / D) + EPS);
#pragma unroll
        for (int j = 0; j < 4; ++j) xr[64 * j] = v[j] * rs * ((const f32x4*)a.in[I_NF])[F.lane + 64 * j]; }
}

__global__ void __launch_bounds__(NTHREADS, 2) fwd(Args args) {
    extern __shared__ __attribute__((aligned(16))) unsigned char lds[];
    Frame F;
    F.lds = (LAS unsigned char*)lds;
    F.tid = threadIdx.x; F.lane = F.tid & 63; F.wave = __builtin_amdgcn_readfirstlane(F.tid >> 6);
    F.G = gridDim.x; { const int bx = blockIdx.x; F.vcu = (F.G % 8 == 0) ? (bx % 8) * (F.G / 8) + bx / 8 : bx; }
    unsigned char* ws = args.ws; F.ws = ws;
    volatile LAS unsigned* MISC = (volatile LAS unsigned*)(F.lds + MISC_OFF);
    for (int u = F.tid; u < (LDS_BYTES - RING_BYTES) / 4; u += NTHREADS) ((LAS unsigned*)(F.lds + RING_BYTES))[u] = 0u;
    __syncthreads();
    XcdBarrier bar; bar.bar = (unsigned*)(ws + WS_CTL); bar.x = 0; bar.st = nullptr;
    if (MK_N_LAUNCHES == 1) bar = xcd_barrier_post((unsigned*)(ws + WS_CTL), MISC + 8);
    const int lo = args.ph_lo, hi = args.ph_hi;
#define IN(k) (lo <= (k) && (k) < hi)
#define SEAM(k) do { if (IN(k) && IN((k) + 1)) xcd_barrier(bar); } while (0)
    using namespace pg8;
    bf16* S0 = (bf16*)(ws + WS_SLOT(0)); bf16* S1 = (bf16*)(ws + WS_SLOT(1)); bf16* S2 = (bf16*)(ws + WS_SLOT(2)); bf16* S3 = (bf16*)(ws + WS_SLOT(3)); bf16* S4 = (bf16*)(ws + WS_SLOT(4)); bf16* S5 = (bf16*)(ws + WS_SLOT(5));
    float* SS1 = (float*)(ws + WS_SS1); float* SS2 = (float*)(ws + WS_SS2);
    const int cid = (int)blockIdx.x;

    if (IN(0)) { p0_prologue(args, F); __syncthreads(); } SEAM(0);
    if (IN(1)) {
        meta_tasks<1>(args, F, 176);
        Gemm g{S0, (const bf16*)(ws + W_GU1), D, D, D, 0}; StaticOrder S; S.init(64, 22, F.G, cid); EpiSwiGLU E{S1, nullptr};
        gemm_phase(F.lds, g, S, E); }
    SEAM(1);
    if (IN(2)) {
        meta_tasks<2>(args, F, 64);
        Gemm g{S1, (const bf16*)(ws + W_D1), DFF, DFF, DFF, 0}; StaticOrder S; S.init(64, 4, F.G, cid); EpiRes<true, true> E{args.in[I_X], args.out, S0, args.in[I_NMIX], SS1};
        gemm_phase(F.lds, g, S, E); }
    SEAM(2);
    if (IN(3)) {
        meta_tasks<3>(args, F, 128);
        Gemm g{S0, (const bf16*)(ws + W_IN), D, D, D, 0}; StaticOrder S; S.init(64, 24, F.G, cid); EpiWin E{SS1, args.in[I_BIN], S0};
        gemm_phase(F.lds, g, S, E); }
    SEAM(3);
    if (IN(4)) { meta_tasks<4>(args, F, 64); phase_conv31(args, F); }
    SEAM(4);
    if (IN(5)) phase_conv4(args, F);
    SEAM(5);
    if (IN(6)) {
        Gemm g{S0, (const bf16*)(ws + W_C), D, D, D, 0}; StaticOrder S; S.init(64, 4, F.G, cid); EpiYb E{S5, args.in[I_BC]};
        gemm_phase(F.lds, g, S, E); }
    SEAM(6);
    if (IN(7)) {
        Gemm g{S3, (const bf16*)(ws + W_G), D, 256, 256, 256}; StaticOrder S; S.init(64, 8, F.G, cid);
        EpiGates E{S3, S0, S1, args.in[I_BA], args.in[I_BX], (const float*)(ws + WS_SMALL + SM_SP8)};
        gemm_phase(F.lds, g, S, E); }
    SEAM(7);
    if (IN(8)) phase_scan1(args, F);
    SEAM(8);
    if (IN(9)) phase_scan2(args, F);
    SEAM(9);
    if (IN(10)) {
        Gemm g{S1, (const bf16*)(ws + W_R), D, D, D, 0}; StaticOrder S; S.init(64, 4, F.G, cid); EpiYa E{S4, S5};
        gemm_phase(F.lds, g, S, E); }
    SEAM(10);
    if (IN(11)) {
        Gemm g{S5, (const bf16*)(ws + W_O), D, D, D, 0}; StaticOrder S; S.init(64, 4, F.G, cid); EpiRes<false, true> E{args.out, args.out, S0, args.in[I_N2], SS2};
        gemm_phase(F.lds, g, S, E); }
    SEAM(11);
    if (IN(12)) {
        Gemm g{S0, (const bf16*)(ws + W_GU2), D, D, D, 0}; StaticOrder S; S.init(64, 22, F.G, cid); EpiSwiGLU E{S1, SS2};
        gemm_phase(F.lds, g, S, E); }
    SEAM(12);
    if (IN(13)) {
        Gemm g{S1, (const bf16*)(ws + W_D2), DFF, DFF, DFF, 0}; StaticOrder S; S.init(64, 4, F.G, cid); EpiRes<true, false> E{args.out, args.out, nullptr, nullptr, nullptr};
        gemm_phase(F.lds, g, S, E); }
    SEAM(13);
    if (IN(14)) phase_final(args, F);
#undef IN
#undef SEAM
}

extern "C" void kernel_launch(void* const* d_in, const int* in_sizes, int n_in, void* d_out, int out_size, void* d_ws, size_t ws_size, hipStream_t stream) {
    static int grid = 0;
    if (grid == 0) {
        if (n_in != 27 || in_sizes[0] != MR * D || out_size != MR * D || ws_size < WS_END) { fprintf(stderr, "kernel_launch: unexpected shapes (n_in %d, in0 %d, out %d, ws %zu)\n", n_in, n_in > 0 ? in_sizes[0] : -1, out_size, ws_size); grid = -1; return; }
        int dev = 0, cus = 0, per_cu = 0;
        if (hipGetDevice(&dev) != hipSuccess || hipDeviceGetAttribute(&cus, hipDeviceAttributeMultiprocessorCount, dev) != hipSuccess) { grid = -1; return; }
        if (hipFuncSetAttribute((const void*)fwd, hipFuncAttributeMaxDynamicSharedMemorySize, LDS_BYTES) != hipSuccess) { fprintf(stderr, "kernel_launch: hipFuncSetAttribute failed\n"); grid = -1; return; }
        if (hipOccupancyMaxActiveBlocksPerMultiprocessor(&per_cu, (const void*)fwd, NTHREADS, LDS_BYTES) != hipSuccess || per_cu < 1) { fprintf(stderr, "kernel_launch: occupancy query says %d blocks per CU\n", per_cu); (void)hipGetLastError(); per_cu = 1; }
        grid = cus;
    }
    if (grid < 0) return;
    (void)hipMemsetAsync((char*)d_ws + WS_CTL, 0, CTL_ZERO_BYTES, stream);
    Args a{};
    for (int i = 0; i < 27; ++i) a.in[i] = (const float*)d_in[i];
    a.out = (float*)d_out; a.ws = (unsigned char*)d_ws;
    if (MK_N_LAUNCHES == 1) {
        a.ph_lo = 0; a.ph_hi = NPH;
        hipLaunchKernelGGL(fwd, dim3(grid), dim3(NTHREADS), LDS_BYTES, stream, a);
    } else {
        for (int p = 0; p < NPH; ++p) { a.ph_lo = p; a.ph_hi = p + 1; hipLaunchKernelGGL(fwd, dim3(grid), dim3(NTHREADS), LDS_BYTES, stream, a); }
    }
}
```

```cpp
#include <hip/hip_runtime.h>
#include <cstdio>
#include <cstdint>

#ifndef MK_N_LAUNCHES
#define MK_N_LAUNCHES 1
#endif

#define GAS __attribute__((address_space(1)))
#define LAS __attribute__((address_space(3)))
typedef unsigned short bf16;
typedef short bf16x8 __attribute__((ext_vector_type(8)));
typedef float f32x4 __attribute__((ext_vector_type(4)));
typedef float f32x2 __attribute__((ext_vector_type(2)));
typedef unsigned u32x4 __attribute__((ext_vector_type(4)));
typedef unsigned u32x2 __attribute__((ext_vector_type(2)));

constexpr int D = 1024, BATCH = 4, SEQ = 4096, NMETA = 16, DFF = 2816, NIN = 6144;
constexpr int MR = BATCH * SEQ;
constexpr int MROW0 = MR;
constexpr int RB = 16448;
constexpr float EPS = 1e-6f;
constexpr int NPH = 15;
constexpr int NWAVES = 8, NTHREADS = 512;

constexpr size_t MiB = 1u << 20;
constexpr size_t WS_CTL = 0, CTL_ZERO_BYTES = 64 * 1024;
constexpr size_t WS_SS1 = 1 * MiB;
constexpr size_t WS_SS2 = 2 * MiB;
constexpr size_t WS_CS = 3 * MiB;
constexpr size_t WS_CH = 4 * MiB;
constexpr size_t WS_SMALL = 5 * MiB;
constexpr size_t SM_SP8 = 0;
constexpr size_t SM_HM = 4096;
constexpr size_t SM_SSM = SM_HM + 65536;
constexpr size_t SM_MLA = SM_SSM + 4096;
constexpr size_t SM_MUU = SM_MLA + 65536;
constexpr size_t WS_W = 6 * MiB;
constexpr size_t W_GU1 = WS_W, W_D1 = W_GU1 + 11 * MiB, W_IN = W_D1 + 5632 * 1024, W_G = W_IN + 12 * MiB, W_R = W_G + 1 * MiB,
                 W_C = W_R + 2 * MiB, W_O = W_C + 2 * MiB, W_GU2 = W_O + 2 * MiB, W_D2 = W_GU2 + 11 * MiB, W_END = W_D2 + 5632 * 1024;
static_assert(W_END == 58 * MiB, "weights map");
constexpr size_t SLOT = (size_t)RB * D * 2;
constexpr size_t WS_S0 = 58 * MiB;
#define WS_SLOT(i) (WS_S0 + (size_t)(i) * SLOT)
constexpr size_t WS_END = WS_S0 + 6 * SLOT;
static_assert(WS_END <= 256 * MiB, "d_ws map");
static_assert((size_t)RB * DFF * 2 <= 3 * SLOT, "U fits slots 1..3");

constexpr int RING_BYTES = 131072;
constexpr int MISC_OFF = RING_BYTES + 320;
constexpr int LDS_BYTES = 147456;

#define RLX_AGENT __ATOMIC_RELAXED, __HIP_MEMORY_SCOPE_AGENT
__device__ __forceinline__ unsigned cvt_pk_bf16(float lo, float hi) { unsigned r; asm volatile("v_cvt_pk_bf16_f32 %0, %1, %2" : "=v"(r) : "v"(lo), "v"(hi)); return r; }
__device__ __forceinline__ float bf_lo(unsigned w) { return __builtin_bit_cast(float, w << 16); }
__device__ __forceinline__ float bf_hi(unsigned w) { return __builtin_bit_cast(float, w & 0xffff0000u); }
__device__ __forceinline__ float bf2f(bf16 h) { return __builtin_bit_cast(float, (unsigned)h << 16); }
__device__ __forceinline__ float fast_exp(float x) { return __builtin_amdgcn_exp2f(x * 1.44269504089f); }
__device__ __forceinline__ float sigmoidf_(float x) { return __builtin_amdgcn_rcpf(1.0f + fast_exp(-x)); }
__device__ __forceinline__ float gelu_tanh(float x) { const float t = 1.5957691216f * (x + 0.044715f * x * x * x); return x * sigmoidf_(t); }
__device__ __forceinline__ float one_minus_exp(float x) { const float big = 1.0f - fast_exp(x), sm = -x * (1.0f + x * (0.5f + x * (0.16666667f + x * 0.041666668f))); return x > -0.1f ? sm : big; }
__device__ __forceinline__ float siluf_(float x) { return x * sigmoidf_(x); }
__device__ __forceinline__ float wave_sum(float v) {
#pragma unroll
    for (int o = 1; o < 64; o <<= 1) v += __shfl_xor(v, o);
    return v;
}
__device__ __forceinline__ float quad_sum(float v) { v += __shfl_xor(v, 16); v += __shfl_xor(v, 32); return v; }

#define XB_TMO      128
#define XB_XCNT(j)  (256  + 64 * (j))
#define XB_XSUB(j)  (1280 + 64 * (j))
#define XB_XGEN(j)  (2304 + 64 * (j))
#define XB_TOP      3328
#define XB_TOPGEN   3392
#define XCD_BAR_WORDS 3456
#define XB_SPIN_CAP (1u << 18)
__device__ __forceinline__ unsigned xb_ld(unsigned* p)              { return __hip_atomic_load(p, __ATOMIC_RELAXED, __HIP_MEMORY_SCOPE_AGENT); }
__device__ __forceinline__ unsigned xb_add(unsigned* p, unsigned v) { return __hip_atomic_fetch_add(p, v, __ATOMIC_RELAXED, __HIP_MEMORY_SCOPE_AGENT); }
__device__ __forceinline__ unsigned xb_xcc_id() { return (unsigned)__builtin_amdgcn_s_getreg((3 << 11) | 20) & 0xFu; }
#define XB_SPIN(cond, bar) do { unsigned _sp = 0; while (cond) { __builtin_amdgcn_s_sleep(1); \
    if ((++_sp & 255u) == 0u) { if (xb_ld(&(bar)[XB_TMO])) break; if (_sp > XB_SPIN_CAP) { atomicAdd(&(bar)[XB_TMO], 1u); break; } } } } while (0)
struct XcdBarrier { unsigned* bar; unsigned x; volatile LAS unsigned* st; };
__device__ __forceinline__ XcdBarrier xcd_barrier_post(unsigned* bar, volatile LAS unsigned* st) {
    XcdBarrier b; b.bar = bar; b.x = xb_xcc_id(); b.st = st;
    if (threadIdx.x == 0) (void)xb_add(&bar[XB_XCNT(b.x)], 1u);
    return b;
}
__device__ __forceinline__ void xcd_barrier_complete(unsigned* bar, unsigned x, unsigned& nloc, unsigned& nx) {
    const unsigned G = gridDim.x * gridDim.y * gridDim.z;
    unsigned sum, cnt, mine, sp = 0u;
    for (;;) {
        sum = 0u; cnt = 0u; mine = 0u;
#pragma unroll
        for (unsigned j = 0; j < 16; ++j) { const unsigned c = xb_ld(&bar[XB_XCNT(j)]); sum += c; cnt += (c > 0u) ? 1u : 0u; mine = (j == x) ? c : mine; }
        if (sum == G) break;
        __builtin_amdgcn_s_sleep(1);
        if ((++sp & 255u) == 0u) { if (xb_ld(&bar[XB_TMO])) break; if (sp > XB_SPIN_CAP) { atomicAdd(&bar[XB_TMO], 1u); break; } }
    }
    nloc = mine > 0u ? mine : 1u; nx = cnt > 0u ? cnt : 1u;
}
__device__ __forceinline__ void xcd_barrier(const XcdBarrier& b) {
    asm volatile("s_waitcnt vmcnt(0)" ::: "memory");
    __syncthreads();
    if (threadIdx.x == 0) {
        unsigned* bar = b.bar;
        __builtin_amdgcn_s_waitcnt(0);
        unsigned nloc = b.st[0], nx = b.st[1];
        if (nloc == 0u) { xcd_barrier_complete(bar, b.x, nloc, nx); b.st[0] = nloc; b.st[1] = nx; }
        const unsigned old = xb_add(&bar[XB_XSUB(b.x)], 1u);
        const unsigned gen = old / nloc;
        if (old + 1u == (gen + 1u) * nloc) {
            __builtin_amdgcn_fence(__ATOMIC_RELEASE, "agent");
            asm volatile("s_waitcnt vmcnt(0)" ::: "memory");
            const unsigned og = xb_add(&bar[XB_TOP], 1u);
            const unsigned tg = og / nx;
            if (og + 1u == (tg + 1u) * nx) xb_add(&bar[XB_TOPGEN], 1u);
            else XB_SPIN(xb_ld(&bar[XB_TOPGEN]) == tg, bar);
            __builtin_amdgcn_fence(__ATOMIC_ACQUIRE, "agent");
            xb_add(&bar[XB_XGEN(b.x)], 1u);
            asm volatile("s_waitcnt vmcnt(0)" ::: "memory");
        } else {
            XB_SPIN(xb_ld(&bar[XB_XGEN(b.x)]) == gen, bar);
            __builtin_amdgcn_fence(__ATOMIC_ACQUIRE, "agent");
            asm volatile("s_waitcnt vmcnt(0)" ::: "memory");
        }
    }
    __syncthreads();
}

namespace pg8 {
constexpr int BM = 256, HALF = 128, NXCD = 8, WGM = 8;
__host__ __device__ __forceinline__ int perm32(int rho) { const int n = rho >> 4, i = rho & 15; return 8 * (i >> 2) + 4 * n + (i & 3); }
struct Unit { int pm, pn; };
struct Gemm { const bf16* A; const bf16* Bt; int lda, ldb, K, a_tile_cols; };
struct StaticOrder {
    int nM, nN, nwg, G, c;
    __device__ void init(int nM_, int nN_, int G_, int c_) { nM = nM_; nN = nN_; nwg = nM * nN; G = G_; c = c_; }
    __device__ bool next(int i, Unit& u) const {
        const long L = (long)i * G + c; if (L >= nwg) return false;
        int wgid = (int)L; { const int q = nwg / NXCD, r = nwg % NXCD, xcd = wgid % NXCD, off = wgid / NXCD; wgid = (xcd < r ? xcd * (q + 1) : r * (q + 1) + (xcd - r) * q) + off; }
        const int nig = WGM * nN, gid = wgid / nig, fm = gid * WGM, gsz = (nM - fm) < WGM ? (nM - fm) : WGM;
        u.pm = fm + ((wgid % nig) % gsz); u.pn = (wgid % nig) / gsz; return true;
    }
};
typedef f32x4 Acc[2][2][4][2];

__device__ __forceinline__ float rowscale(const float* ss, int row, int fq) {
    const f32x4 p = *(const f32x4*)(ss + (size_t)row * 16 + 4 * fq);
    const float s = quad_sum((p[0] + p[1]) + (p[2] + p[3]));
    return 1.0f / sqrtf(s * (1.0f / D) + EPS);
}
__device__ __forceinline__ u32x4 pack8(const f32x4 a, const f32x4 b) { u32x4 w; w.x = cvt_pk_bf16(a[0], a[1]); w.y = cvt_pk_bf16(a[2], a[3]); w.z = cvt_pk_bf16(b[0], b[1]); w.w = cvt_pk_bf16(b[2], b[3]); return w; }
__device__ __forceinline__ void unpack8(const u32x4 w, f32x4& a, f32x4& b) { a = (f32x4){bf_lo(w.x), bf_hi(w.x), bf_lo(w.y), bf_hi(w.y)}; b = (f32x4){bf_lo(w.z), bf_hi(w.z), bf_lo(w.w), bf_hi(w.w)}; }

struct EpiSwiGLU {
    bf16* U; const float* ss;
    __device__ __forceinline__ void operator()(const Acc& acc, const Unit& u, int wr, int wc, int fr, int fq) const {
        const int row0 = u.pm * BM + wr * 64 + fr, col0 = u.pn * HALF + wc * 32 + 8 * fq;
#pragma unroll
        for (int ai = 0; ai < 2; ++ai)
#pragma unroll
            for (int m = 0; m < 4; ++m) { const int row = row0 + ai * HALF + m * 16; const float rs = ss ? rowscale(ss, row, fq) : 1.0f;
                f32x4 o[2];
#pragma unroll
                for (int n = 0; n < 2; ++n) { const f32x4 g = acc[ai][0][m][n] * rs, v = acc[ai][1][m][n] * rs;
#pragma unroll
                    for (int i = 0; i < 4; ++i) o[n][i] = g[i] * v[i] * sigmoidf_(g[i]); }
                *(u32x4*)(U + (size_t)row * DFF + col0) = pack8(o[0], o[1]); }
    }
};
template <bool HALFSC, bool HAS_A> struct EpiRes {
    const float* base; float* hout; bf16* aout; const float* gvec; float* ssout;
    __device__ __forceinline__ void operator()(const Acc& acc, const Unit& u, int wr, int wc, int fr, int fq) const {
        const int row0 = u.pm * BM + wr * 64 + fr, col0 = u.pn * BM + wc * 32 + 8 * fq;
        const float scale = HALFSC ? 0.5f : 1.0f;
        f32x4 gv[2][2];
#pragma unroll
        for (int bj = 0; bj < 2; ++bj)
#pragma unroll
            for (int n = 0; n < 2; ++n) gv[bj][n] = HAS_A ? *(const f32x4*)(gvec + col0 + bj * HALF + 4 * n) : (f32x4){0.f, 0.f, 0.f, 0.f};
#pragma unroll
        for (int ai = 0; ai < 2; ++ai)
#pragma unroll
            for (int m = 0; m < 4; ++m) { const int row = row0 + ai * HALF + m * 16; const size_t off = (size_t)row * D + col0; float q = 0.f;
#pragma unroll
                for (int bj = 0; bj < 2; ++bj) { f32x4 h[2];
#pragma unroll
                    for (int n = 0; n < 2; ++n) { const f32x4 b = *(const f32x4*)(base + off + bj * HALF + 4 * n); h[n] = b + acc[ai][bj][m][n] * scale;
                        *(f32x4*)(hout + off + bj * HALF + 4 * n) = h[n]; q += (h[n][0] * h[n][0] + h[n][1] * h[n][1]) + (h[n][2] * h[n][2] + h[n][3] * h[n][3]); }
                    if (HAS_A) *(u32x4*)(aout + off + bj * HALF) = pack8(h[0] * gv[bj][0], h[1] * gv[bj][1]); }
                if (HAS_A) { q = quad_sum(q); if (fq == 0) ssout[(size_t)row * 16 + u.pn * 4 + wc] = q; } }
    }
};
struct EpiWin {
    const float* ss; const float* b_in; bf16* s0;
    __device__ __forceinline__ void operator()(const Acc& acc, const Unit& u, int wr, int wc, int fr, int fq) const {
        const int row0 = u.pm * BM + wr * 64 + fr, cc0 = wc * 32 + 8 * fq; const int pn = u.pn;
        if (pn >= 8 && pn < 16) {
            const int q = pn - 8, col = q * HALF + cc0;
            f32x4 bv[2][2];
#pragma unroll
            for (int bj = 0; bj < 2; ++bj)
#pragma unroll
                for (int n = 0; n < 2; ++n) bv[bj][n] = *(const f32x4*)(b_in + 2048 + bj * 1024 + col + 4 * n);
#pragma unroll
            for (int ai = 0; ai < 2; ++ai)
#pragma unroll
                for (int m = 0; m < 4; ++m) { const int row = row0 + ai * HALF + m * 16; const float rs = rowscale(ss, row, fq); f32x4 o[2];
#pragma unroll
                    for (int n = 0; n < 2; ++n) { const f32x4 a = acc[ai][0][m][n] * rs + bv[0][n], g = acc[ai][1][m][n] * rs + bv[1][n];
#pragma unroll
                        for (int i = 0; i < 4; ++i) o[n][i] = a[i] * sigmoidf_(g[i]); }
                    *(u32x4*)(s0 + 3 * (SLOT / 2) + (size_t)row * D + col) = pack8(o[0], o[1]); }
        } else {
            const int act = pn < 4 ? 0 : (pn < 8 ? 1 : 2);
            const int si = pn < 4 ? 1 : (pn < 8 ? 2 : (pn < 20 ? 4 : 5)); bf16* O = s0 + (size_t)si * (SLOT / 2);
            const int scol = pn * BM + cc0, ocol = (pn & 3) * BM + cc0;
            f32x4 bv[2][2];
#pragma unroll
            for (int bj = 0; bj < 2; ++bj)
#pragma unroll
                for (int n = 0; n < 2; ++n) bv[bj][n] = *(const f32x4*)(b_in + scol + bj * HALF + 4 * n);
#pragma unroll
            for (int ai = 0; ai < 2; ++ai)
#pragma unroll
                for (int m = 0; m < 4; ++m) { const int row = row0 + ai * HALF + m * 16; const float rs = rowscale(ss, row, fq);
#pragma unroll
                    for (int bj = 0; bj < 2; ++bj) { f32x4 o[2];
#pragma unroll
                        for (int n = 0; n < 2; ++n) { o[n] = acc[ai][bj][m][n] * rs + bv[bj][n];
                            if (act == 1) {
#pragma unroll
                                for (int i = 0; i < 4; ++i) o[n][i] = gelu_tanh(o[n][i]); }
                            else if (act == 2) {
#pragma unroll
                                for (int i = 0; i < 4; ++i) o[n][i] = sigmoidf_(o[n][i]); } }
                        *(u32x4*)(O + (size_t)row * D + ocol + bj * HALF) = pack8(o[0], o[1]); } }
        }
    }
};
struct EpiYb {
    bf16* sb; const float* bias;
    __device__ __forceinline__ void operator()(const Acc& acc, const Unit& u, int wr, int wc, int fr, int fq) const {
        const int row0 = u.pm * BM + wr * 64 + fr, col0 = u.pn * BM + wc * 32 + 8 * fq;
        f32x4 bv[2][2];
#pragma unroll
        for (int bj = 0; bj < 2; ++bj)
#pragma unroll
            for (int n = 0; n < 2; ++n) bv[bj][n] = *(const f32x4*)(bias + col0 + bj * HALF + 4 * n);
#pragma unroll
        for (int ai = 0; ai < 2; ++ai)
#pragma unroll
            for (int m = 0; m < 4; ++m) { const size_t off = (size_t)(row0 + ai * HALF + m * 16) * D + col0;
#pragma unroll
                for (int bj = 0; bj < 2; ++bj) { f32x4 s0, s1; unpack8(*(const u32x4*)(sb + off + bj * HALF), s0, s1);
                    *(u32x4*)(sb + off + bj * HALF) = pack8(s0 * (acc[ai][bj][m][0] + bv[bj][0]), s1 * (acc[ai][bj][m][1] + bv[bj][1])); } }
    }
};
struct EpiYa {
    const bf16* sa; bf16* mb;
    __device__ __forceinline__ void operator()(const Acc& acc, const Unit& u, int wr, int wc, int fr, int fq) const {
        const int row0 = u.pm * BM + wr * 64 + fr, col0 = u.pn * BM + wc * 32 + 8 * fq;
#pragma unroll
        for (int ai = 0; ai < 2; ++ai)
#pragma unroll
            for (int m = 0; m < 4; ++m) { const size_t off = (size_t)(row0 + ai * HALF + m * 16) * D + col0;
#pragma unroll
                for (int bj = 0; bj < 2; ++bj) { f32x4 s0, s1, b0, b1; unpack8(*(const u32x4*)(sa + off + bj * HALF), s0, s1); unpack8(*(const u32x4*)(mb + off + bj * HALF), b0, b1);
                    *(u32x4*)(mb + off + bj * HALF) = pack8(s0 * acc[ai][bj][m][0] + b0, s1 * acc[ai][bj][m][1] + b1); } }
    }
};
struct EpiGates {
    const bf16* xr; bf16 *la, *uu; const float *b_a, *b_x, *sp8;
    __device__ __forceinline__ void operator()(const Acc& acc, const Unit& u, int wr, int wc, int fr, int fq) const {
        const int row0 = u.pm * BM + wr * 64 + fr, col0 = u.pn * HALF + wc * 32 + 8 * fq;
#pragma unroll
        for (int ai = 0; ai < 2; ++ai)
#pragma unroll
            for (int m = 0; m < 4; ++m) { const size_t off = (size_t)(row0 + ai * HALF + m * 16) * D + col0;
                f32x4 x[2]; unpack8(*(const u32x4*)(xr + off), x[0], x[1]); f32x4 ol[2], ou[2];
#pragma unroll
                for (int n = 0; n < 2; ++n) { const f32x4 ba = *(const f32x4*)(b_a + col0 + 4 * n), bx = *(const f32x4*)(b_x + col0 + 4 * n), sp = *(const f32x4*)(sp8 + col0 + 4 * n);
#pragma unroll
                    for (int i = 0; i < 4; ++i) { const float r = sigmoidf_(acc[ai][0][m][n][i] + ba[i]), ig = sigmoidf_(acc[ai][1][m][n][i] + bx[i]);
                        const float l = -r * sp[i]; ol[n][i] = l; ou[n][i] = __builtin_amdgcn_sqrtf(one_minus_exp(2.0f * l)) * ig * x[n][i]; } }
                *(u32x4*)(la + off) = pack8(ol[0], ol[1]); *(u32x4*)(uu + off) = pack8(ou[0], ou[1]); }
    }
};

#define PG8_LAS __attribute__((address_space(3)))
constexpr int BK = 64, HTB = HALF * BK * 2  , STAGE_BYTES = 8 * HTB;
__host__ __device__ __forceinline__ int lds_byte(int r, int c) { const int st = (r >> 4) * 2 + (c >> 5), rr = r & 15, cc = c & 31, ob = rr * 64 + cc * 2; return st * 1024 + (ob ^ (((ob >> 9) & 1) << 5)); }
__host__ __device__ __forceinline__ void stage_rc(int b, int& R, int& C) { const int st = b / 1024, sb = b % 1024, swz = sb ^ (((sb >> 9) & 1) << 5); R = (st >> 1) * 16 + swz / 64; C = (st & 1) * 32 + (swz % 64) / 2; }
template <class Epi, class Sched, bool ALIGN_EPI = true, bool SP2 = true>
__device__ __forceinline__ void gemm_phase(PG8_LAS unsigned char* lds, const Gemm g, const Sched& S, const Epi& E) {
    const int tid = threadIdx.x, wid = __builtin_amdgcn_readfirstlane(tid >> 6), lane = tid & 63, wr = wid >> 2, wc = wid & 3, fr = lane & 15, fq = lane >> 4;
    const int K = g.K, nt = K / BK;
    unsigned voffA[2], voffB[2];
#pragma unroll
    for (int i = 0; i < 2; ++i) { int R, C; stage_rc(tid * 16 + i * 8192, R, C); const int Rb = (R & ~31) + perm32(R & 31);
        voffA[i] = (unsigned)(R * g.lda + C) * 2u; voffB[i] = (unsigned)(Rb * g.ldb + C) * 2u; }
    const size_t kstep = (size_t)(BK * 2);
    const size_t hstepA = (size_t)HALF * g.lda * 2, hstepB = (size_t)HALF * g.ldb * 2;
    const size_t tstepA = 2 * hstepA, tstepB = 2 * hstepB;
    const size_t acolB = (size_t)g.a_tile_cols * 2;
    const unsigned ldsw = (unsigned)wid * 1024u;
    const int aoff = lds_byte(wr * 64 + fr, fq * 8), boff = lds_byte(wc * 32 + fr, fq * 8);
#define PG8_SA(b, h) (((b) * 2 + (h)) * HTB)
#define PG8_SB(b, h) ((4 + (b) * 2 + (h)) * HTB)
#define PG8_STAGE(bufoff, gbase, voff) do { _Pragma("unroll") for (int _i = 0; _i < 2; ++_i) \
        __builtin_amdgcn_global_load_lds((const unsigned*)((const char*)(gbase) + (voff)[_i]), (PG8_LAS unsigned*)(lds + (bufoff) + ldsw + _i * 8192), 16, 0, 0); } while (0)
#define PG8_LDA(dst, b, h) do { _Pragma("unroll") for (int m = 0; m < 4; ++m) _Pragma("unroll") for (int k = 0; k < 2; ++k) dst[m][k] = *(const PG8_LAS bf16x8*)(lds + PG8_SA(b, h) + aoff + m * 2048 + k * 1024); } while (0)
#define PG8_LDB(dst, b, h) do { _Pragma("unroll") for (int n = 0; n < 2; ++n) _Pragma("unroll") for (int k = 0; k < 2; ++k) dst[n][k] = *(const PG8_LAS bf16x8*)(lds + PG8_SB(b, h) + boff + n * 2048 + k * 1024); } while (0)
#define PG8_MMA(ai, bj, At, Bt) do { __builtin_amdgcn_s_setprio(1); _Pragma("unroll") for (int m = 0; m < 4; ++m) _Pragma("unroll") for (int n = 0; n < 2; ++n) _Pragma("unroll") for (int k = 0; k < 2; ++k) \
        acc[ai][bj][m][n] = __builtin_amdgcn_mfma_f32_16x16x32_bf16(Bt[n][k], At[m][k], acc[ai][bj][m][n], 0, 0, 0); __builtin_amdgcn_s_setprio(0); } while (0)
#define PG8_WAIT_V(n) asm volatile("s_waitcnt vmcnt(" #n ")" ::: "memory")
#define PG8_WAIT_L(n) asm volatile("s_waitcnt lgkmcnt(" #n ")" ::: "memory")
#define PG8_BAR __builtin_amdgcn_s_barrier()
#define PG8_SCHED __builtin_amdgcn_sched_barrier(0)
    Unit cur, nxt; int ui = 0;
    if (!S.next(0, cur)) return;
    Acc acc;
#pragma unroll
    for (int a = 0; a < 2; ++a)
#pragma unroll
        for (int b = 0; b < 2; ++b)
#pragma unroll
            for (int m = 0; m < 4; ++m)
#pragma unroll
                for (int n = 0; n < 2; ++n) acc[a][b][m][n] = (f32x4){0.f, 0.f, 0.f, 0.f};
    bf16x8 At[4][2], B0[2][2], B1[2][2];
    const char* cA = (const char*)g.A + (size_t)cur.pm * tstepA + (size_t)(cur.pn >> 1) * acolB; const char* cB = (const char*)g.Bt + (size_t)cur.pn * tstepB;
    if constexpr (SP2) {
        PG8_STAGE(PG8_SB(0, 0), cB, voffB); PG8_STAGE(PG8_SB(0, 1), cB + hstepB, voffB); PG8_STAGE(PG8_SA(0, 0), cA, voffA); PG8_STAGE(PG8_SA(0, 1), cA + hstepA, voffA);
        if (wr == 1) PG8_BAR;
        PG8_WAIT_V(2); PG8_BAR;
        PG8_STAGE(PG8_SB(1, 0), cB + kstep, voffB); PG8_STAGE(PG8_SA(1, 0), cA + kstep, voffA); PG8_STAGE(PG8_SB(1, 1), cB + hstepB + kstep, voffB);
        PG8_WAIT_V(6); PG8_BAR;
    } else {
        PG8_STAGE(PG8_SB(0, 0), cB, voffB); PG8_STAGE(PG8_SA(0, 0), cA, voffA); PG8_STAGE(PG8_SB(0, 1), cB + hstepB, voffB); PG8_STAGE(PG8_SA(0, 1), cA + hstepA, voffA);
        if (wr == 1) PG8_BAR;
        PG8_WAIT_V(4); PG8_BAR;
        PG8_STAGE(PG8_SB(1, 0), cB + kstep, voffB); PG8_STAGE(PG8_SA(1, 0), cA + kstep, voffA); PG8_STAGE(PG8_SB(1, 1), cB + hstepB + kstep, voffB);
        PG8_WAIT_V(6); PG8_BAR;
    }
    for (;;) {
        const bool has_next = S.next(ui + 1, nxt);
        const char* nA = has_next ? (const char*)g.A + (size_t)nxt.pm * tstepA + (size_t)(nxt.pn >> 1) * acolB : cA; const char* nB = has_next ? (const char*)g.Bt + (size_t)nxt.pn * tstepB : cB;
        for (int t = 0; t < nt; t += 2) {
            const bool last = (t == nt - 2);
            const char* a1 = cA + (size_t)(t + 1) * kstep;
            const char* a2 = last ? nA : cA + (size_t)(t + 2) * kstep; const char* b2 = last ? nB : cB + (size_t)(t + 2) * kstep;
            const char* a3 = a2 + kstep; const char* b3 = b2 + kstep;
            if constexpr (SP2) {
            PG8_LDB(B0, 0, 0); PG8_LDB(B1, 0, 1); PG8_SCHED; PG8_LDA(At, 0, 0); PG8_STAGE(PG8_SA(1, 1), a1 + hstepA, voffA);
            PG8_WAIT_V(8); PG8_WAIT_L(0); PG8_BAR; PG8_MMA(0, 0, At, B0); PG8_MMA(0, 1, At, B1); PG8_BAR; PG8_SCHED;
            PG8_LDA(At, 0, 1); PG8_STAGE(PG8_SB(0, 0), b2, voffB); PG8_STAGE(PG8_SB(0, 1), b2 + hstepB, voffB); PG8_STAGE(PG8_SA(0, 0), a2, voffA);
            PG8_WAIT_V(8); PG8_WAIT_L(0); PG8_BAR; PG8_MMA(1, 0, At, B0); PG8_MMA(1, 1, At, B1); PG8_BAR; PG8_SCHED;
            PG8_LDB(B0, 1, 0); PG8_LDB(B1, 1, 1); PG8_SCHED; PG8_LDA(At, 1, 0); PG8_STAGE(PG8_SA(0, 1), a2 + hstepA, voffA);
            PG8_WAIT_V(8); PG8_WAIT_L(0); PG8_BAR; PG8_MMA(0, 0, At, B0); PG8_MMA(0, 1, At, B1); PG8_BAR; PG8_SCHED;
            PG8_LDA(At, 1, 1); PG8_STAGE(PG8_SB(1, 0), b3, voffB); PG8_STAGE(PG8_SB(1, 1), b3 + hstepB, voffB); PG8_STAGE(PG8_SA(1, 0), a3, voffA);
            PG8_WAIT_V(8); PG8_WAIT_L(0); PG8_BAR; PG8_MMA(1, 0, At, B0); PG8_MMA(1, 1, At, B1); PG8_BAR; PG8_SCHED;
            } else {
            PG8_LDB(B0, 0, 0); PG8_SCHED; PG8_LDA(At, 0, 0); PG8_STAGE(PG8_SA(1, 1), a1 + hstepA, voffA);
            PG8_WAIT_L(8); PG8_BAR; PG8_WAIT_L(0); PG8_MMA(0, 0, At, B0); PG8_BAR; PG8_SCHED;
            PG8_LDB(B1, 0, 1); PG8_STAGE(PG8_SB(0, 0), b2, voffB);
            PG8_BAR; PG8_WAIT_L(0); PG8_MMA(0, 1, At, B1); PG8_BAR;
            PG8_LDA(At, 0, 1); PG8_STAGE(PG8_SA(0, 0), a2, voffA);
            PG8_BAR; PG8_WAIT_L(0); PG8_MMA(1, 0, At, B0); PG8_BAR; PG8_SCHED;
            PG8_STAGE(PG8_SB(0, 1), b2 + hstepB, voffB);
            PG8_WAIT_V(6); PG8_BAR; PG8_MMA(1, 1, At, B1); PG8_BAR;
            PG8_LDB(B0, 1, 0); PG8_SCHED; PG8_LDA(At, 1, 0); PG8_STAGE(PG8_SA(0, 1), a2 + hstepA, voffA);
            PG8_WAIT_L(8); PG8_BAR; PG8_WAIT_L(0); PG8_MMA(0, 0, At, B0); PG8_BAR; PG8_SCHED;
            PG8_LDB(B1, 1, 1); PG8_STAGE(PG8_SB(1, 0), b3, voffB);
            PG8_BAR; PG8_WAIT_L(0); PG8_MMA(0, 1, At, B1); PG8_BAR;
            PG8_LDA(At, 1, 1); PG8_STAGE(PG8_SA(1, 0), a3, voffA);
            PG8_BAR; PG8_WAIT_L(0); PG8_MMA(1, 0, At, B0); PG8_BAR; PG8_SCHED;
            PG8_STAGE(PG8_SB(1, 1), b3 + hstepB, voffB);
            PG8_WAIT_V(6); PG8_BAR; PG8_MMA(1, 1, At, B1); PG8_BAR;
            }
        }
        if constexpr (ALIGN_EPI) { if (wr == 0) PG8_BAR; }
        E(acc, cur, wr, wc, fr, fq);
        if (!has_next) break;
#pragma unroll
        for (int a = 0; a < 2; ++a)
#pragma unroll
            for (int b = 0; b < 2; ++b)
#pragma unroll
                for (int m = 0; m < 4; ++m)
#pragma unroll
                    for (int n = 0; n < 2; ++n) acc[a][b][m][n] = (f32x4){0.f, 0.f, 0.f, 0.f};
        cur = nxt; cA = nA; cB = nB; ++ui;
        if constexpr (ALIGN_EPI) { if (wr == 1) PG8_BAR; }
    }
    PG8_WAIT_V(0);
    if constexpr (!ALIGN_EPI) { if (wr == 0) PG8_BAR; }
    PG8_BAR;
#undef PG8_SA
#undef PG8_SB
#undef PG8_STAGE
#undef PG8_LDA
#undef PG8_LDB
#undef PG8_MMA
#undef PG8_WAIT_V
#undef PG8_WAIT_L
#undef PG8_BAR
#undef PG8_SCHED
}

}

struct Frame {
    LAS unsigned char* lds;
    int tid, lane, wave, vcu, G;
    unsigned char* ws;
};
struct Args { const float* in[27]; float* out; unsigned char* ws; int ph_lo, ph_hi; };
enum { I_X = 0, I_META, I_N1, I_GU1, I_D1, I_NMIX, I_WIN, I_BIN, I_CW4, I_CB4, I_WA, I_BA, I_WX, I_BX, I_LAM, I_WR, I_CW31, I_CB31, I_LNG, I_LNB, I_WC, I_BC, I_WO, I_N2, I_GU2, I_D2, I_NF };

__device__ __forceinline__ int row_of(int b, int q) { return q >= NMETA ? b * SEQ + (q - NMETA) : MROW0 + q; }

__device__ __forceinline__ void transpose_item(const float* src, int ld, int scol, int k0, bf16* dst, int drow, int K, LAS float* scr, int lane) {
#pragma unroll 8
    for (int i = 0; i < 32; ++i) { const int kk = 2 * i + (lane >> 5); scr[kk * 33 + (lane & 31)] = src[(size_t)(k0 + kk) * ld + scol + (lane & 31)]; }
    asm volatile("s_waitcnt lgkmcnt(0)" ::: "memory");
    const int c = lane & 7;
#pragma unroll
    for (int j = 0; j < 4; ++j) { const int n = (lane >> 3) + 8 * j; const LAS float* s = scr + (8 * c) * 33 + n;
        u32x4 o; o.x = cvt_pk_bf16(s[0 * 33], s[1 * 33]); o.y = cvt_pk_bf16(s[2 * 33], s[3 * 33]); o.z = cvt_pk_bf16(s[4 * 33], s[5 * 33]); o.w = cvt_pk_bf16(s[6 * 33], s[7 * 33]);
        *(u32x4*)(dst + (size_t)(drow + n) * K + k0 + 8 * c) = o; }
    asm volatile("s_waitcnt lgkmcnt(0)" ::: "memory");
}
__device__ __forceinline__ void wsrc(const Args& a, int kind, int d, const float*& src, int& ld, int& col) {
    switch (kind) {
        case 0: case 7: { src = a.in[kind == 0 ? I_GU1 : I_GU2]; ld = 2 * DFF; col = (d & 1) * DFF + 128 * (d >> 1); break; }
        case 1: case 8: { src = a.in[kind == 1 ? I_D1 : I_D2]; ld = D; col = 128 * d; break; }
        case 2: { src = a.in[I_WIN]; ld = NIN; if (d >= 16 && d < 32) { const int e = d - 16; col = 2048 + (e & 1) * 1024 + 128 * (e >> 1); } else col = 128 * d; break; }
        case 3: { const int h = d >> 2, q = (d >> 1) & 1; src = a.in[(d & 1) ? I_WX : I_WA] + (size_t)h * 256 * 256; ld = 256; col = 128 * q; break; }
        case 4: { src = a.in[I_WR]; ld = D; col = 128 * d; break; }
        case 5: { src = a.in[I_WC]; ld = D; col = 128 * d; break; }
        default: { src = a.in[I_WO]; ld = D; col = 128 * d; break; }
    }
}
__device__ __forceinline__ void rms_row_to_bf16(const float* xrow, const float* g, bf16* orow, int lane) {
    const f32x4* xr = (const f32x4*)xrow + lane; f32x4 v[4]; float s = 0.f;
#pragma unroll
    for (int j = 0; j < 4; ++j) { v[j] = xr[64 * j]; s += (v[j][0] * v[j][0] + v[j][1] * v[j][1]) + (v[j][2] * v[j][2] + v[j][3] * v[j][3]); }
    const float rs = 1.0f / sqrtf(wave_sum(s) * (1.0f / D) + EPS);
#pragma unroll
    for (int j = 0; j < 4; ++j) { const f32x4 gg = ((const f32x4*)g)[lane + 64 * j]; const f32x4 o = v[j] * rs * gg;
        u32x2 w; w.x = cvt_pk_bf16(o[0], o[1]); w.y = cvt_pk_bf16(o[2], o[3]); ((u32x2*)orow)[lane + 64 * j] = w; }
}
__device__ __forceinline__ void p0_prologue(const Args& a, Frame& F) {
    LAS float* scr = (LAS float*)(F.lds + F.wave * 16384);
    const int gw = F.vcu * NWAVES + F.wave, NGW = F.G * NWAVES;
    const int   mK[9]  = {D, DFF, D, 256, D, D, D, D, DFF};
    const int   mNB[9] = {44, 8, 48, 16, 8, 8, 8, 44, 8};
    const size_t mDst[9] = {W_GU1, W_D1, W_IN, W_G, W_R, W_C, W_O, W_GU2, W_D2};
    int base = 0;
#pragma unroll
    for (int kind = 0; kind < 9; ++kind) {
        const int K = mK[kind], nkb = K / 64, nitems = mNB[kind] * 4 * nkb;
        bf16* dst = (bf16*)(a.ws + mDst[kind]);
        int first = (gw - base % NGW + NGW) % NGW;
        for (int it = first; it < nitems; it += NGW) {
            const int kb = it % nkb, ns = it / nkb, d = ns >> 2, s = ns & 3;
            const float* src; int ld, col; wsrc(a, kind, d, src, ld, col);
            transpose_item(src, ld, col + 32 * s, 64 * kb, dst, 128 * d + 32 * s, K, scr, F.lane);
        }
        base += nitems;
    }
    { float* sp8 = (float*)(a.ws + WS_SMALL + SM_SP8); const int gt = F.vcu * NTHREADS + F.tid; if (gt < D) sp8[gt] = 8.0f * log1pf(expf(-a.in[I_LAM][gt])); }
    bf16* A1 = (bf16*)(a.ws + WS_SLOT(0));
    for (int r = gw; r < MR + NMETA; r += NGW) { const float* xrow = r < MR ? a.in[I_X] + (size_t)r * D : a.in[I_META] + (size_t)(r - MR) * D; rms_row_to_bf16(xrow, a.in[I_N1], A1 + (size_t)r * D, F.lane); }
}

__device__ __forceinline__ f32x4 meta_dot(const bf16* arow  , const bf16* brow  , int K) {
    f32x4 acc = {0.f, 0.f, 0.f, 0.f};
#pragma unroll 4
    for (int k0 = 0; k0 < K; k0 += 32) { const bf16x8 af = *(const bf16x8*)(arow + k0), bfr = *(const bf16x8*)(brow + k0); acc = __builtin_amdgcn_mfma_f32_16x16x32_bf16(bfr, af, acc, 0, 0, 0); }
    return acc;
}
__device__ __forceinline__ void meta_m1(const Args& a, int t, int lane) {
    const int fr = lane & 15, fq = lane >> 4; const bf16* A1 = (const bf16*)(a.ws + WS_SLOT(0)); const bf16* W = (const bf16*)(a.ws + W_GU1); bf16* U = (bf16*)(a.ws + WS_SLOT(1));
    const int c0 = 16 * t, pn = c0 >> 7, cc = c0 & 127; const bf16* ar = A1 + (size_t)(MROW0 + fr) * D + 8 * fq;
    const f32x4 g = meta_dot(ar, W + (size_t)(256 * pn + cc + fr) * D + 8 * fq, D), v = meta_dot(ar, W + (size_t)(256 * pn + 128 + cc + fr) * D + 8 * fq, D);
    u32x2 w; w.x = cvt_pk_bf16(g[0] * v[0] * sigmoidf_(g[0]), g[1] * v[1] * sigmoidf_(g[1])); w.y = cvt_pk_bf16(g[2] * v[2] * sigmoidf_(g[2]), g[3] * v[3] * sigmoidf_(g[3]));
    *(u32x2*)(U + (size_t)(MROW0 + fr) * DFF + c0 + 4 * fq) = w;
}
__device__ __forceinline__ void meta_m2(const Args& a, int t, int lane) {
    const int fr = lane & 15, fq = lane >> 4; const bf16* U = (const bf16*)(a.ws + WS_SLOT(1)); const bf16* W = (const bf16*)(a.ws + W_D1);
    const int c0 = 16 * t + 4 * fq;
    const f32x4 acc = meta_dot(U + (size_t)(MROW0 + fr) * DFF + 8 * fq, W + (size_t)(16 * t + fr) * DFF + 8 * fq, DFF);
    const f32x4 h = *(const f32x4*)(a.in[I_META] + (size_t)fr * D + c0) + acc * 0.5f;
    *(f32x4*)((float*)(a.ws + WS_SMALL + SM_HM) + (size_t)fr * D + c0) = h;
    const f32x4 o = h * *(const f32x4*)(a.in[I_NMIX] + c0); u32x2 w; w.x = cvt_pk_bf16(o[0], o[1]); w.y = cvt_pk_bf16(o[2], o[3]);
    *(u32x2*)((bf16*)(a.ws + WS_SLOT(0)) + (size_t)(MROW0 + fr) * D + c0) = w;
    const float q = quad_sum((h[0] * h[0] + h[1] * h[1]) + (h[2] * h[2] + h[3] * h[3]));
    if (fq == 0) ((float*)(a.ws + WS_SMALL + SM_SSM))[fr * 64 + t] = q;
}
__device__ __forceinline__ void meta_m3(const Args& a, int t, int lane) {
    const int fr = lane & 15, fq = lane >> 4; const bf16* A2 = (const bf16*)(a.ws + WS_SLOT(0)); const bf16* W = (const bf16*)(a.ws + W_IN);
    const float* ssm = (const float*)(a.ws + WS_SMALL + SM_SSM) + fr * 64 + 16 * fq; float s = 0.f;
#pragma unroll
    for (int j = 0; j < 4; ++j) { const f32x4 p = *(const f32x4*)(ssm + 4 * j); s += (p[0] + p[1]) + (p[2] + p[3]); }
    const float rs = 1.0f / sqrtf(quad_sum(s) * (1.0f / D) + EPS);
    const bf16* ar = A2 + (size_t)(MROW0 + fr) * D + 8 * fq;
    if (t < 64) { const int c0 = 16 * t;
        const f32x4 acc = meta_dot(ar, W + (size_t)(c0 + fr) * D + 8 * fq, D);
        const f32x4 o = acc * rs + *(const f32x4*)(a.in[I_BIN] + c0 + 4 * fq); u32x2 w; w.x = cvt_pk_bf16(o[0], o[1]); w.y = cvt_pk_bf16(o[2], o[3]);
        *(u32x2*)((bf16*)(a.ws + WS_SLOT(1)) + (size_t)(MROW0 + fr) * D + c0 + 4 * fq) = w;
    } else { const int c0 = 16 * (t - 64), q = c0 >> 7, cc = c0 & 127;
        const f32x4 av = meta_dot(ar, W + (size_t)(2048 + 256 * q + cc + fr) * D + 8 * fq, D), ag = meta_dot(ar, W + (size_t)(2048 + 256 * q + 128 + cc + fr) * D + 8 * fq, D);
        const f32x4 vv = av * rs + *(const f32x4*)(a.in[I_BIN] + 2048 + c0 + 4 * fq), gg = ag * rs + *(const f32x4*)(a.in[I_BIN] + 3072 + c0 + 4 * fq);
        u32x2 w; w.x = cvt_pk_bf16(vv[0] * sigmoidf_(gg[0]), vv[1] * sigmoidf_(gg[1])); w.y = cvt_pk_bf16(vv[2] * sigmoidf_(gg[2]), vv[3] * sigmoidf_(gg[3]));
        *(u32x2*)((bf16*)(a.ws + WS_SLOT(3)) + (size_t)(MROW0 + fr) * D + c0 + 4 * fq) = w;
    }
}
__device__ __forceinline__ float meta_conv4(const Args& a, const bf16* X, int m, int c) {
    float s = a.in[I_CB4][c];
#pragma unroll
    for (int k = 0; k < 4; ++k) { const int mm = m - 3 + k; if (mm >= 0) s += a.in[I_CW4][k * D + c] * bf2f(X[(size_t)(MROW0 + mm) * D + c]); }
    return s;
}
__device__ __forceinline__ void meta_m4(const Args& a, int t, int lane) {
    const int fr = lane & 15, fq = lane >> 4; const bf16* X = (const bf16*)(a.ws + WS_SLOT(1)); const bf16* W = (const bf16*)(a.ws + W_G);
    const int c0 = 16 * t, h = c0 >> 8, q = (c0 >> 7) & 1, cc = c0 & 127;
    const bf16* br = W + (size_t)((2 * h + q) * 256 + cc + fr) * 256 + 8 * fq; const bf16* bi = br + (size_t)128 * 256;
    f32x4 ar = {0.f, 0.f, 0.f, 0.f}, ai = {0.f, 0.f, 0.f, 0.f};
    for (int k0 = 0; k0 < 256; k0 += 32) { bf16x8 af;
#pragma unroll
        for (int j = 0; j < 8; j += 2) { const unsigned w = cvt_pk_bf16(meta_conv4(a, X, fr, 256 * h + k0 + 8 * fq + j), meta_conv4(a, X, fr, 256 * h + k0 + 8 * fq + j + 1)); af[j] = (short)(w & 0xffffu); af[j + 1] = (short)(w >> 16); }
        ar = __builtin_amdgcn_mfma_f32_16x16x32_bf16(*(const bf16x8*)(br + k0), af, ar, 0, 0, 0); ai = __builtin_amdgcn_mfma_f32_16x16x32_bf16(*(const bf16x8*)(bi + k0), af, ai, 0, 0, 0); }
    const float* sp8 = (const float*)(a.ws + WS_SMALL + SM_SP8); f32x4 ol, ou;
#pragma unroll
    for (int i = 0; i < 4; ++i) { const int c = c0 + 4 * fq + i; const float r = sigmoidf_(ar[i] + a.in[I_BA][c]), ig = sigmoidf_(ai[i] + a.in[I_BX][c]);
        const float l = -r * sp8[c]; ol[i] = l; ou[i] = __builtin_amdgcn_sqrtf(one_minus_exp(2.0f * l)) * ig * meta_conv4(a, X, fr, c); }
    *(f32x4*)((float*)(a.ws + WS_SMALL + SM_MLA) + (size_t)fr * D + c0 + 4 * fq) = ol; *(f32x4*)((float*)(a.ws + WS_SMALL + SM_MUU) + (size_t)fr * D + c0 + 4 * fq) = ou;
}
template <int WHICH> __device__ __forceinline__ void meta_tasks(const Args& a, Frame& F, int ntasks) {
    for (int t = F.wave * F.G + (int)blockIdx.x; t < ntasks; t += NWAVES * F.G) {
        if (WHICH == 1) meta_m1(a, t, F.lane); else if (WHICH == 2) meta_m2(a, t, F.lane); else if (WHICH == 3) meta_m3(a, t, F.lane); else meta_m4(a, t, F.lane);
    }
}

__device__ __forceinline__ f32x2 ld_bf2(const bf16* p) { const unsigned w = *(const unsigned*)p; return (f32x2){bf_lo(w), bf_hi(w)}; }
__device__ __forceinline__ void phase_conv31(const Args& a, Frame& F) {
    const bf16* V = (const bf16*)(a.ws + WS_SLOT(3)); bf16* O = (bf16*)(a.ws + WS_SLOT(0));
    LAS float* cv = (LAS float*)F.lds;
    const int c0 = 2 * F.tid;
    f32x2 wk[31];
#pragma unroll
    for (int k = 0; k < 31; ++k) wk[k] = *(const f32x2*)(a.in[I_CW31] + k * D + c0);
    const f32x2 bias = *(const f32x2*)(a.in[I_CB31] + c0);
    for (int u = F.vcu; u < 256; u += F.G) {
        const int b = u >> 6, t0 = (u & 63) * 64;
        f32x2 win[38];
#pragma unroll
        for (int i = 0; i < 30; ++i) { const int q = NMETA + t0 - 30 + i; win[i] = q >= 0 ? ld_bf2(V + (size_t)row_of(b, q) * D + c0) : (f32x2){0.f, 0.f}; }
        for (int grp = 0; grp < 4; ++grp) {
#pragma unroll
            for (int sub = 0; sub < 2; ++sub) {
                const int tb = t0 + grp * 16 + sub * 8;
#pragma unroll
                for (int j = 0; j < 8; ++j) win[30 + j] = ld_bf2(V + (size_t)(b * SEQ + tb + j) * D + c0);
#pragma unroll
                for (int j = 0; j < 8; ++j) { f32x2 o = bias;
#pragma unroll
                    for (int k = 0; k < 31; ++k) o += wk[k] * win[j + k];
                    *(LAS f32x2*)(cv + (sub * 8 + j) * D + c0) = o; }
#pragma unroll
                for (int i = 0; i < 30; ++i) win[i] = win[i + 8];
            }
            __syncthreads();
#pragma unroll
            for (int tt = 0; tt < 2; ++tt) { const int tok = 2 * F.wave + tt; const LAS f32x4* rowp = (const LAS f32x4*)(cv + tok * D) + F.lane;
                f32x4 x[4]; float s = 0.f;
#pragma unroll
                for (int j = 0; j < 4; ++j) { x[j] = rowp[64 * j]; s += (x[j][0] + x[j][1]) + (x[j][2] + x[j][3]); }
                const float mean = wave_sum(s) * (1.0f / D); float s2 = 0.f;
#pragma unroll
                for (int j = 0; j < 4; ++j) { x[j] = x[j] - mean; s2 += (x[j][0] * x[j][0] + x[j][1] * x[j][1]) + (x[j][2] * x[j][2] + x[j][3] * x[j][3]); }
                const float rstd = 1.0f / sqrtf(wave_sum(s2) * (1.0f / D) + EPS);
                bf16* orow = O + (size_t)(b * SEQ + t0 + grp * 16 + tok) * D;
#pragma unroll
                for (int j = 0; j < 4; ++j) { const f32x4 g = ((const f32x4*)a.in[I_LNG])[F.lane + 64 * j], bb = ((const f32x4*)a.in[I_LNB])[F.lane + 64 * j]; const f32x4 y = x[j] * rstd * g + bb;
                    u32x2 w; w.x = cvt_pk_bf16(siluf_(y[0]), siluf_(y[1])); w.y = cvt_pk_bf16(siluf_(y[2]), siluf_(y[3])); ((u32x2*)orow)[F.lane + 64 * j] = w; } }
            __syncthreads();
        }
    }
}
__device__ __forceinline__ void phase_conv4(const Args& a, Frame& F) {
    const bf16* X = (const bf16*)(a.ws + WS_SLOT(1)); bf16* O = (bf16*)(a.ws + WS_SLOT(3));
    const int gt = F.vcu * NTHREADS + F.tid, NT = F.G * NTHREADS;
    for (int it = gt; it < MR * 128; it += NT) {
        const int r = it >> 7, c = (it & 127) * 8, b = r >> 12, p = NMETA + (r & 4095);
        f32x4 o0 = *(const f32x4*)(a.in[I_CB4] + c), o1 = *(const f32x4*)(a.in[I_CB4] + c + 4);
#pragma unroll
        for (int k = 0; k < 4; ++k) { f32x4 x0, x1; pg8::unpack8(*(const u32x4*)(X + (size_t)row_of(b, p - 3 + k) * D + c), x0, x1);
            o0 += *(const f32x4*)(a.in[I_CW4] + k * D + c) * x0; o1 += *(const f32x4*)(a.in[I_CW4] + k * D + c + 4) * x1; }
        *(u32x4*)(O + (size_t)r * D + c) = pg8::pack8(o0, o1);
    }
}
__device__ __forceinline__ void phase_scan1(const Args& a, Frame& F) {
    const bf16* LA = (const bf16*)(a.ws + WS_SLOT(0)); const bf16* UU = (const bf16*)(a.ws + WS_SLOT(1));
    float* CS = (float*)(a.ws + WS_CS); float* CH = (float*)(a.ws + WS_CH);
    const int c0 = 2 * F.tid;
    for (int u = F.vcu; u < 256; u += F.G) {
        const size_t r0 = (size_t)u * 64; f32x2 S = {0.f, 0.f}, H = {0.f, 0.f};
#pragma unroll 16
        for (int t = 0; t < 64; ++t) { const f32x2 l = ld_bf2(LA + (r0 + t) * D + c0), x = ld_bf2(UU + (r0 + t) * D + c0);
            H.x = fast_exp(l.x) * H.x + x.x; H.y = fast_exp(l.y) * H.y + x.y; S += l; }
        *(f32x2*)(CS + (size_t)u * D + c0) = S; *(f32x2*)(CH + (size_t)u * D + c0) = H;
    }
}
__device__ __forceinline__ void phase_scan2(const Args& a, Frame& F) {
    const bf16* LA = (const bf16*)(a.ws + WS_SLOT(0)); bf16* UU = (bf16*)(a.ws + WS_SLOT(1)); const bf16* GY = (const bf16*)(a.ws + WS_SLOT(2));
    const float* CS = (const float*)(a.ws + WS_CS); const float* CH = (const float*)(a.ws + WS_CH);
    const float* MLA = (const float*)(a.ws + WS_SMALL + SM_MLA); const float* MUU = (const float*)(a.ws + WS_SMALL + SM_MUU);
    const int c0 = 2 * F.tid;
    for (int u = F.vcu; u < 256; u += F.G) {
        const int b = u >> 6, j = u & 63; const size_t r0 = (size_t)u * 64; f32x2 h = {0.f, 0.f};
#pragma unroll
        for (int s = 0; s < NMETA; ++s) { const f32x2 l = *(const f32x2*)(MLA + s * D + c0), x = *(const f32x2*)(MUU + s * D + c0); h.x = fast_exp(l.x) * h.x + x.x; h.y = fast_exp(l.y) * h.y + x.y; }
        for (int jj = 0; jj < j; ++jj) { const f32x2 l = *(const f32x2*)(CS + (size_t)(b * 64 + jj) * D + c0), x = *(const f32x2*)(CH + (size_t)(b * 64 + jj) * D + c0); h.x = fast_exp(l.x) * h.x + x.x; h.y = fast_exp(l.y) * h.y + x.y; }
#pragma unroll 16
        for (int t = 0; t < 64; ++t) { const f32x2 l = ld_bf2(LA + (r0 + t) * D + c0), x = ld_bf2(UU + (r0 + t) * D + c0), g = ld_bf2(GY + (r0 + t) * D + c0);
            h.x = fast_exp(l.x) * h.x + x.x; h.y = fast_exp(l.y) * h.y + x.y;
            *(unsigned*)(UU + (r0 + t) * D + c0) = cvt_pk_bf16(h.x * g.x, h.y * g.y); }
    }
}
__device__ __forceinline__ void phase_final(const Args& a, Frame& F) {
    const int gw = F.vcu * NWAVES + F.wave, NGW = F.G * NWAVES;
    for (int r = gw; r < MR; r += NGW) { f32x4* xr = (f32x4*)(a.out + (size_t)r * D) + F.lane; f32x4 v[4]; float s = 0.f;
#pragma unroll
        for (int j = 0; j < 4; ++j) { v[j] = xr[64 * j]; s += (v[j][0] * v[j][0] + v[j][1] * v[j][1]) + (v[j][2] * v[j][2] + v[j][3] * v[j][3]); }
        const float rs = 1.0f / sqrtf(wave_sum(s) * (1.0f / D) + EPS);
#pragma unroll
        for (int j = 0; j < 4; ++j) xr[64 * j] = v[j] * rs * ((const f32x4*)a.in[I_NF])[F.lane + 64 * j]; }
}

__global__ void __launch_bounds__(NTHREADS, 2) fwd(Args args) {
    extern __shared__ __attribute__((aligned(16))) unsigned char lds[];
    Frame F;
    F.lds = (LAS unsigned char*)lds;
    F.tid = threadIdx.x; F.lane = F.tid & 63; F.wave = __builtin_amdgcn_readfirstlane(F.tid >> 6);
    F.G = gridDim.x; { const int bx = blockIdx.x; F.vcu = (F.G % 8 == 0) ? (bx % 8) * (F.G / 8) + bx / 8 : bx; }
    unsigned char* ws = args.ws; F.ws = ws;
    volatile LAS unsigned* MISC = (volatile LAS unsigned*)(F.lds + MISC_OFF);
    for (int u = F.tid; u < (LDS_BYTES - RING_BYTES) / 4; u += NTHREADS) ((LAS unsigned*)(F.lds + RING_BYTES))[u] = 0u;
    __syncthreads();
    XcdBarrier bar; bar.bar = (unsigned*)(ws + WS_CTL); bar.x = 0; bar.st = nullptr;
    if (MK_N_LAUNCHES == 1) bar = xcd_barrier_post((unsigned*)(ws + WS_CTL), MISC + 8);
    const int lo = args.ph_lo, hi = args.ph_hi;
#define IN(k) (lo <= (k) && (k) < hi)
#define SEAM(k) do { if (IN(k) && IN((k) + 1)) xcd_barrier(bar); } while (0)
    using namespace pg8;
    bf16* S0 = (bf16*)(ws + WS_SLOT(0)); bf16* S1 = (bf16*)(ws + WS_SLOT(1)); bf16* S2 = (bf16*)(ws + WS_SLOT(2)); bf16* S3 = (bf16*)(ws + WS_SLOT(3)); bf16* S4 = (bf16*)(ws + WS_SLOT(4)); bf16* S5 = (bf16*)(ws + WS_SLOT(5));
    float* SS1 = (float*)(ws + WS_SS1); float* SS2 = (float*)(ws + WS_SS2);
    const int cid = (int)blockIdx.x;

    if (IN(0)) { p0_prologue(args, F); __syncthreads(); } SEAM(0);
    if (IN(1)) {
        meta_tasks<1>(args, F, 176);
        Gemm g{S0, (const bf16*)(ws + W_GU1), D, D, D, 0}; StaticOrder S; S.init(64, 22, F.G, cid); EpiSwiGLU E{S1, nullptr};
        gemm_phase(F.lds, g, S, E); }
    SEAM(1);
    if (IN(2)) {
        meta_tasks<2>(args, F, 64);
        Gemm g{S1, (const bf16*)(ws + W_D1), DFF, DFF, DFF, 0}; StaticOrder S; S.init(64, 4, F.G, cid); EpiRes<true, true> E{args.in[I_X], args.out, S0, args.in[I_NMIX], SS1};
        gemm_phase(F.lds, g, S, E); }
    SEAM(2);
    if (IN(3)) {
        meta_tasks<3>(args, F, 128);
        Gemm g{S0, (const bf16*)(ws + W_IN), D, D, D, 0}; StaticOrder S; S.init(64, 24, F.G, cid); EpiWin E{SS1, args.in[I_BIN], S0};
        gemm_phase(F.lds, g, S, E); }
    SEAM(3);
    if (IN(4)) { meta_tasks<4>(args, F, 64); phase_conv31(args, F); }
    SEAM(4);
    if (IN(5)) phase_conv4(args, F);
    SEAM(5);
    if (IN(6)) {
        Gemm g{S0, (const bf16*)(ws + W_C), D, D, D, 0}; StaticOrder S; S.init(64, 4, F.G, cid); EpiYb E{S5, args.in[I_BC]};
        gemm_phase(F.lds, g, S, E); }
    SEAM(6);
    if (IN(7)) {
        Gemm g{S3, (const bf16*)(ws + W_G), D, 256, 256, 256}; StaticOrder S; S.init(64, 8, F.G, cid);
        EpiGates E{S3, S0, S1, args.in[I_BA], args.in[I_BX], (const float*)(ws + WS_SMALL + SM_SP8)};
        gemm_phase(F.lds, g, S, E); }
    SEAM(7);
    if (IN(8)) phase_scan1(args, F);
    SEAM(8);
    if (IN(9)) phase_scan2(args, F);
    SEAM(9);
    if (IN(10)) {
        Gemm g{S1, (const bf16*)(ws + W_R), D, D, D, 0}; StaticOrder S; S.init(64, 4, F.G, cid); EpiYa E{S4, S5};
        gemm_phase(F.lds, g, S, E); }
    SEAM(10);
    if (IN(11)) {
        Gemm g{S5, (const bf16*)(ws + W_O), D, D, D, 0}; StaticOrder S; S.init(64, 4, F.G, cid); EpiRes<false, true> E{args.out, args.out, S0, args.in[I_N2], SS2};
        gemm_phase(F.lds, g, S, E); }
    SEAM(11);
    if (IN(12)) {
        Gemm g{S0, (const bf16*)(ws + W_GU2), D, D, D, 0}; StaticOrder S; S.init(64, 22, F.G, cid); EpiSwiGLU E{S1, SS2};
        gemm_phase(F.lds, g, S, E); }
    SEAM(12);
    if (IN(13)) {
        Gemm g{S1, (const bf16*)(ws + W_D2), DFF, DFF, DFF, 0}; StaticOrder S; S.init(64, 4, F.G, cid); EpiRes<true, false> E{args.out, args.out, nullptr, nullptr, nullptr};
        gemm_phase(F.lds, g, S, E); }
    SEAM(13);
    if (IN(14)) phase_final(args, F);
#undef IN
#undef SEAM
}

extern "C" void kernel_launch(void* const* d_in, const int* in_sizes, int n_in, void* d_out, int out_size, void* d_ws, size_t ws_size, hipStream_t stream) {
    static int grid = 0;
    if (grid == 0) {
        if (n_in != 27 || in_sizes[0] != MR * D || out_size != MR * D || ws_size < WS_END) { fprintf(stderr, "kernel_launch: unexpected shapes (n_in %d, in0 %d, out %d, ws %zu)\n", n_in, n_in > 0 ? in_sizes[0] : -1, out_size, ws_size); grid = -1; return; }
        int dev = 0, cus = 0, per_cu = 0;
        if (hipGetDevice(&dev) != hipSuccess || hipDeviceGetAttribute(&cus, hipDeviceAttributeMultiprocessorCount, dev) != hipSuccess) { grid = -1; return; }
        if (hipFuncSetAttribute((const void*)fwd, hipFuncAttributeMaxDynamicSharedMemorySize, LDS_BYTES) != hipSuccess) { fprintf(stderr, "kernel_launch: hipFuncSetAttribute failed\n"); grid = -1; return; }
        if (hipOccupancyMaxActiveBlocksPerMultiprocessor(&per_cu, (const void*)fwd, NTHREADS, LDS_BYTES) != hipSuccess || per_cu < 1) { fprintf(stderr, "kernel_launch: occupancy query says %d blocks per CU\n", per_cu); (void)hipGetLastError(); per_cu = 1; }
        grid = cus;
    }
    if (grid < 0) return;
    (void)hipMemsetAsync((char*)d_ws + WS_CTL, 0, CTL_ZERO_BYTES, stream);
    Args a{};
    for (int i = 0; i < 27; ++i) a.in[i] = (const float*)d_in[i];
    a.out = (float*)d_out; a.ws = (unsigned char*)d_ws;
    if (MK_N_LAUNCHES == 1) {
        a.ph_lo = 0; a.ph_hi = NPH;
        hipLaunchKernelGGL(fwd, dim3(grid), dim3(NTHREADS), LDS_BYTES, stream, a);
    } else {
        for (int p = 0; p < NPH; ++p) { a.ph_lo = p; a.ph_hi = p + 1; hipLaunchKernelGGL(fwd, dim3(grid), dim3(NTHREADS), LDS_BYTES, stream, a); }
    }
}
```
